# Optimizing an MI355X kernel written in HIP

```python
import jax, jax.numpy as jnp
from jax import lax
import numpy as np

D_MODEL = 1024
BATCH = 4
SEQ = 8192
DEPTH = 4

HEAD_DIM = 64
A_HEADS = 8
A_KV_HEADS = 2
B_HEADS = 8
B_KV_HEADS = 2
WINDOW = 128
BLOCK = 128
ROPE_THETA = 10000.0
GRID_W = 64
SGU_WIDTH = D_MODEL
SGU_GROUPS = 8
SGU_CHUNK = 128
D_FF = 4 * D_MODEL
EPS = 1e-6
N_ATT_LAYERS = (DEPTH + 1) // 2
N_SGU_LAYERS = DEPTH // 2

A_Q = A_HEADS * HEAD_DIM
A_KV = A_KV_HEADS * HEAD_DIM
B_Q = B_HEADS * HEAD_DIM
B_KV = B_KV_HEADS * HEAD_DIM
ATT_IN = A_Q + 2 * A_KV + B_Q + 2 * B_KV
ATT_OUT_IN = A_Q + B_Q

kernel_name = "hybrid_window_grid_attn_sgu_encoder"


def _rmsnorm(x, g):
    xf = x.astype(jnp.float32)
    y = xf * lax.rsqrt(jnp.mean(xf * xf, axis=-1, keepdims=True) + EPS)
    return (y * g.astype(jnp.float32)).astype(x.dtype)


def _layernorm(x, g, b):
    xf = x.astype(jnp.float32)
    mu = jnp.mean(xf, axis=-1, keepdims=True)
    var = jnp.mean(jnp.square(xf - mu), axis=-1, keepdims=True)
    y = (xf - mu) * lax.rsqrt(var + EPS)
    return (y * g.astype(jnp.float32) + b.astype(jnp.float32)).astype(x.dtype)


def _rope_angles(pos, dim):
    freqs = ROPE_THETA ** (-jnp.arange(0, dim, 2, dtype=jnp.float32) / dim)
    ang = pos.astype(jnp.float32)[:, None] * freqs[None, :]
    return jnp.cos(ang), jnp.sin(ang)


def _apply_rope(x, cos, sin):
    xf = x.astype(jnp.float32)
    half = xf.shape[-1] // 2
    x1, x2 = xf[..., :half], xf[..., half:]
    c, s = cos[None, :, None, :], sin[None, :, None, :]
    return jnp.concatenate([x1 * c - x2 * s, x2 * c + x1 * s], axis=-1).astype(x.dtype)


def _apply_axial_rope(x, cos_r, sin_r, cos_c, sin_c):
    half = x.shape[-1] // 2
    return jnp.concatenate([_apply_rope(x[..., :half], cos_r, sin_r),
                            _apply_rope(x[..., half:], cos_c, sin_c)], axis=-1)


def _window_attention(q, k, v, sink):
    bsz, s_len = q.shape[0], q.shape[1]
    nb = s_len // BLOCK
    g = A_HEADS // A_KV_HEADS
    scale = HEAD_DIM ** -0.5
    qb = q.reshape(bsz, nb, BLOCK, A_KV_HEADS, g, HEAD_DIM).astype(jnp.float32)
    pad = ((0, 0), (BLOCK, BLOCK), (0, 0), (0, 0))
    kp = jnp.pad(k, pad).reshape(bsz, nb + 2, BLOCK, A_KV_HEADS, HEAD_DIM)
    vp = jnp.pad(v, pad).reshape(bsz, nb + 2, BLOCK, A_KV_HEADS, HEAD_DIM)
    kband = jnp.concatenate([kp[:, :-2], kp[:, 1:-1], kp[:, 2:]], axis=2).astype(jnp.float32)
    vband = jnp.concatenate([vp[:, :-2], vp[:, 1:-1], vp[:, 2:]], axis=2).astype(jnp.float32)
    s = jnp.einsum('bnqhgd,bnjhd->bnhgqj', qb, kband) * scale
    qi = jnp.arange(BLOCK)
    kj = jnp.arange(3 * BLOCK)
    rel = kj[None, :] - BLOCK - qi[:, None]
    kpos = jnp.arange(nb)[:, None] * BLOCK - BLOCK + kj[None, :]
    mask = (jnp.abs(rel) <= WINDOW)[None, :, :] & ((kpos >= 0) & (kpos < s_len))[:, None, :]
    s = jnp.where(mask[None, :, None, None, :, :], s, -1e30)
    sink_b = sink.astype(jnp.float32).reshape(A_KV_HEADS, g)[None, None, :, :, None, None]
    m = jnp.maximum(jnp.max(s, axis=-1, keepdims=True), sink_b)
    p = jnp.exp(s - m)
    denom = jnp.sum(p, axis=-1, keepdims=True) + jnp.exp(sink_b - m)
    o = jnp.einsum('bnhgqj,bnjhd->bnqhgd', p / denom, vband)
    return o.reshape(bsz, s_len, A_Q).astype(q.dtype)


def _grid_attention(q, k, v):
    bsz, s_len = q.shape[0], q.shape[1]
    nb = s_len // BLOCK
    g = B_HEADS // B_KV_HEADS
    scale = HEAD_DIM ** -0.5
    qb = q.reshape(bsz, nb, BLOCK, B_KV_HEADS, g, HEAD_DIM).transpose(1, 0, 2, 3, 4, 5)
    kf = k.astype(jnp.float32)
    vf = v.astype(jnp.float32)

    def one_block(qblk):
        s = jnp.einsum('bqhgd,bkhd->bhgqk', qblk.astype(jnp.float32), kf) * scale
        p = jax.nn.softmax(s, axis=-1)
        return jnp.einsum('bhgqk,bkhd->bqhgd', p, vf)

    o = lax.map(one_block, qb)
    return o.transpose(1, 0, 2, 3, 4, 5).reshape(bsz, s_len, B_Q).astype(q.dtype)


def _attention_layer(x, norm_g, w_in, sink, qn_g, kn_g, w_out,
                     cos1, sin1, cos_r, sin_r, cos_c, sin_c):
    bsz, s_len = x.shape[0], x.shape[1]
    h = _rmsnorm(x, norm_g)
    proj = h @ w_in
    offs = [A_Q, A_Q + A_KV, A_Q + 2 * A_KV, A_Q + 2 * A_KV + B_Q, A_Q + 2 * A_KV + B_Q + B_KV]
    qa, ka, va, qb, kb, vb = jnp.split(proj, offs, axis=-1)
    qa = qa.reshape(bsz, s_len, A_HEADS, HEAD_DIM)
    ka = ka.reshape(bsz, s_len, A_KV_HEADS, HEAD_DIM)
    va = va.reshape(bsz, s_len, A_KV_HEADS, HEAD_DIM)
    qb = qb.reshape(bsz, s_len, B_HEADS, HEAD_DIM)
    kb = kb.reshape(bsz, s_len, B_KV_HEADS, HEAD_DIM)
    vb = vb.reshape(bsz, s_len, B_KV_HEADS, HEAD_DIM)
    qa = _apply_rope(qa, cos1, sin1)
    ka = _apply_rope(ka, cos1, sin1)
    oa = _window_attention(qa, ka, va, sink)
    qb = _apply_axial_rope(_rmsnorm(qb, qn_g), cos_r, sin_r, cos_c, sin_c)
    kb = _apply_axial_rope(_rmsnorm(kb, kn_g), cos_r, sin_r, cos_c, sin_c)
    ob = _grid_attention(qb, kb, vb)
    return x + jnp.concatenate([oa, ob], axis=-1) @ w_out


def _sgu_layer(x, norm_g, w_in, ln_g, ln_b, w_s, b_s, w_out):
    bsz, s_len = x.shape[0], x.shape[1]
    nc = s_len // SGU_CHUNK
    dg = SGU_WIDTH // SGU_GROUPS
    h = _rmsnorm(x, norm_g)
    z = jax.nn.gelu(h @ w_in)
    u, v = jnp.split(z, 2, axis=-1)
    v = _layernorm(v, ln_g, ln_b)
    vb = v.reshape(bsz, nc, SGU_CHUNK, SGU_GROUPS, dg)
    mixed = jnp.einsum('gpq,bnqgd->bnpgd', w_s, vb) + b_s.T[None, None, :, :, None]
    y = u * mixed.reshape(bsz, s_len, SGU_WIDTH)
    return x + y @ w_out


def _mlp(x, norm_g, w1, w2):
    h = _rmsnorm(x, norm_g)
    return x + jnp.square(jax.nn.relu(h @ w1)) @ w2


def setup_inputs(seed: int = 0) -> dict:
    key = jax.random.key(seed)
    ks = jax.random.split(key, 20)
    f32 = jnp.float32
    nrm = lambda k, shape, s: jax.random.normal(k, shape, f32) * s
    return {
        "x": jax.random.normal(ks[0], (BATCH, SEQ, D_MODEL), f32),
        "att_norm": 1.0 + nrm(ks[1], (N_ATT_LAYERS, D_MODEL), 0.02),
        "att_w_in": nrm(ks[2], (N_ATT_LAYERS, D_MODEL, ATT_IN), D_MODEL ** -0.5),
        "att_sink": nrm(ks[3], (N_ATT_LAYERS, A_HEADS), 0.5),
        "att_qnorm": 1.0 + nrm(ks[4], (N_ATT_LAYERS, HEAD_DIM), 0.02),
        "att_knorm": 1.0 + nrm(ks[5], (N_ATT_LAYERS, HEAD_DIM), 0.02),
        "att_w_out": nrm(ks[6], (N_ATT_LAYERS, ATT_OUT_IN, D_MODEL), ATT_OUT_IN ** -0.5),
        "sgu_norm": 1.0 + nrm(ks[7], (N_SGU_LAYERS, D_MODEL), 0.02),
        "sgu_w_in": nrm(ks[8], (N_SGU_LAYERS, D_MODEL, 2 * SGU_WIDTH), D_MODEL ** -0.5),
        "sgu_ln_g": 1.0 + nrm(ks[9], (N_SGU_LAYERS, SGU_WIDTH), 0.02),
        "sgu_ln_b": nrm(ks[10], (N_SGU_LAYERS, SGU_WIDTH), 0.02),
        "sgu_w_s": nrm(ks[11], (N_SGU_LAYERS, SGU_GROUPS, SGU_CHUNK, SGU_CHUNK), SGU_CHUNK ** -0.5),
        "sgu_b_s": 1.0 + nrm(ks[12], (N_SGU_LAYERS, SGU_GROUPS, SGU_CHUNK), 0.1),
        "sgu_w_out": nrm(ks[13], (N_SGU_LAYERS, SGU_WIDTH, D_MODEL), SGU_WIDTH ** -0.5),
        "mlp_norm": 1.0 + nrm(ks[14], (DEPTH, D_MODEL), 0.02),
        "mlp_w1": nrm(ks[15], (DEPTH, D_MODEL, D_FF), D_MODEL ** -0.5),
        "mlp_w2": nrm(ks[16], (DEPTH, D_FF, D_MODEL), D_FF ** -0.5),
        "final_norm": 1.0 + nrm(ks[17], (D_MODEL,), 0.02),
    }


def reference(x, att_norm, att_w_in, att_sink, att_qnorm, att_knorm, att_w_out,
              sgu_norm, sgu_w_in, sgu_ln_g, sgu_ln_b, sgu_w_s, sgu_b_s, sgu_w_out,
              mlp_norm, mlp_w1, mlp_w2, final_norm):
    s_len = x.shape[1]
    pos = jnp.arange(s_len)
    rows = s_len // GRID_W
    row_idx = jnp.repeat(jnp.arange(rows), GRID_W)
    col_idx = jnp.tile(jnp.arange(GRID_W), rows)
    cos1, sin1 = _rope_angles(pos, HEAD_DIM)
    cos_r, sin_r = _rope_angles(row_idx, HEAD_DIM // 2)
    cos_c, sin_c = _rope_angles(col_idx, HEAD_DIM // 2)
    h = x
    for layer in range(DEPTH):
        i = layer // 2
        if layer % 2 == 0:
            h = _attention_layer(h, att_norm[i], att_w_in[i], att_sink[i], att_qnorm[i],
                                 att_knorm[i], att_w_out[i],
                                 cos1, sin1, cos_r, sin_r, cos_c, sin_c)
        else:
            h = _sgu_layer(h, sgu_norm[i], sgu_w_in[i], sgu_ln_g[i], sgu_ln_b[i],
                           sgu_w_s[i], sgu_b_s[i], sgu_w_out[i])
        h = _mlp(h, mlp_norm[layer], mlp_w1[layer], mlp_w2[layer])
    return _rmsnorm(h, final_norm)
```

```cpp
#include <hip/hip_runtime.h>
#include <hip/hip_cooperative_groups.h>
#include <cstdio>
#include <cstdint>
namespace cg = cooperative_groups;
#ifndef MK_ONE_LAUNCH
#define MK_ONE_LAUNCH 1
#endif
namespace pg8 {
#define PG8_LAS __attribute__((address_space(3)))
typedef unsigned short bf16_t;
typedef short bf16x8 __attribute__((ext_vector_type(8)));
typedef float f32x4 __attribute__((ext_vector_type(4)));
typedef unsigned u32x4 __attribute__((ext_vector_type(4)));
constexpr int BM = 256, BK = 64, HALF = 128, HTB = HALF * BK * 2  , STAGE_BYTES = 8 * HTB, NXCD = 8, WGM = 8;

__host__ __device__ __forceinline__ int lds_byte(int r, int c) { const int st = (r >> 4) * 2 + (c >> 5), rr = r & 15, cc = c & 31, ob = rr * 64 + cc * 2; return st * 1024 + (ob ^ (((ob >> 9) & 1) << 5)); }
__host__ __device__ __forceinline__ void stage_rc(int b, int& R, int& C) { const int st = b / 1024, sb = b % 1024, swz = sb ^ (((sb >> 9) & 1) << 5); R = (st >> 1) * 16 + swz / 64; C = (st & 1) * 32 + (swz % 64) / 2; }
__host__ __device__ __forceinline__ int perm32(int rho) { const int n = rho >> 4, i = rho & 15; return 8 * (i >> 2) + 4 * n + (i & 3); }

struct Unit { int pm, pn; };
struct Gemm { const bf16_t* A; const bf16_t* Bt; int M, N, K; };

struct StaticOrder {
    int nM, nN, nwg, G, c, rev;
    __host__ __device__ void init(int M, int N, int G_, int c_, int rev_ = 0) { nM = M / BM; nN = N / BM; nwg = nM * nN; G = G_; c = c_; rev = rev_; }
    __host__ __device__ bool next(int i, Unit& u) const {
        const int nr = (nwg + G - 1) / G; if (i >= nr) return false;
        const long L = (long)(rev ? nr - 1 - i : i) * G + c; if (L >= nwg) return false;
        int wgid = (int)L; { const int q = nwg / NXCD, r = nwg % NXCD, xcd = wgid % NXCD, off = wgid / NXCD; wgid = (xcd < r ? xcd * (q + 1) : r * (q + 1) + (xcd - r) * q) + off; }
        const int nig = WGM * nN, gid = wgid / nig, fm = gid * WGM, gsz = (nM - fm) < WGM ? (nM - fm) : WGM;
        u.pm = fm + ((wgid % nig) % gsz); u.pn = (wgid % nig) / gsz; return true;
    }
    __device__ __forceinline__ void a_ready(const Unit&) const {}
    __device__ __forceinline__ void done(const Unit&) const {}
};
__device__ __forceinline__ unsigned cvt_pk_bf16(float lo, float hi) { unsigned r; asm volatile("v_cvt_pk_bf16_f32 %0, %1, %2" : "=v"(r) : "v"(lo), "v"(hi)); return r; }
typedef float f32x2 __attribute__((ext_vector_type(2)));
typedef unsigned u32x2 __attribute__((ext_vector_type(2)));
__device__ __forceinline__ float act_relu2(float v) { const float t = fmaxf(v, 0.f); return t * t; }
__device__ __forceinline__ float act_gelu_tanh(float v) {
    const float u = v * (0.7978845608028654f + 0.035677408136300125f * v * v);
    const float e = __builtin_amdgcn_exp2f(u * -2.885390081777927f);
    return v * __builtin_amdgcn_rcpf(1.0f + e);
}
struct EpiBf16 {
    static constexpr bool PERM = true, AFTER_DRAIN = false;
    bf16_t* O; int ldc; int act; const float* ssq;
    __device__ __forceinline__ void operator()(const f32x4 (&acc)[2][2][4][2], const Unit& u, int wr, int wc, int fr, int fq) const {
        const int row0 = u.pm * BM + wr * 64 + fr; const int col0 = u.pn * BM + wc * 32 + 8 * fq;
        f32x4 sv8[2][4]; float rs8[2][4];
#pragma unroll
        for (int ai = 0; ai < 2; ++ai)
#pragma unroll
            for (int m = 0; m < 4; ++m) sv8[ai][m] = *((const f32x4*)(ssq + (size_t)(row0 + ai * HALF + m * 16) * 16) + fq);
#pragma unroll
        for (int ai = 0; ai < 2; ++ai)
#pragma unroll
            for (int m = 0; m < 4; ++m) { float tot = (sv8[ai][m][0] + sv8[ai][m][1]) + (sv8[ai][m][2] + sv8[ai][m][3]); tot += __shfl_xor(tot, 16); tot += __shfl_xor(tot, 32);
                rs8[ai][m] = __builtin_amdgcn_rsqf(tot * (1.0f / 1024.0f) + 1e-6f); }
#pragma unroll
        for (int ai = 0; ai < 2; ++ai)
#pragma unroll
            for (int m = 0; m < 4; ++m) { const int row = row0 + ai * HALF + m * 16; bf16_t* rowp = O + (size_t)row * ldc + col0;
                const float rs = rs8[ai][m];
#pragma unroll
                for (int bj = 0; bj < 2; ++bj) { f32x4 v0 = acc[ai][bj][m][0] * rs, v1 = acc[ai][bj][m][1] * rs;
                    if (act == 1) {
#pragma unroll
                        for (int j = 0; j < 4; ++j) { v0[j] = act_relu2(v0[j]); v1[j] = act_relu2(v1[j]); }
                    } else if (act == 2) {
#pragma unroll
                        for (int j = 0; j < 4; ++j) { v0[j] = act_gelu_tanh(v0[j]); v1[j] = act_gelu_tanh(v1[j]); }
                    }
                    u32x4 w; w.x = cvt_pk_bf16(v0[0], v0[1]); w.y = cvt_pk_bf16(v0[2], v0[3]); w.z = cvt_pk_bf16(v1[0], v1[1]); w.w = cvt_pk_bf16(v1[2], v1[3]);
                    *(u32x4*)(rowp + bj * HALF) = w; } }
    }
    __device__ __forceinline__ void fused(f32x4 (&)[2][2][4][2], const Unit&, int, int, int, int, PG8_LAS unsigned char*, int, int) const {}
};
struct EpiResid {
    static constexpr bool PERM = true, AFTER_DRAIN = false;
    bf16_t* hb; float* ssq; int ldc;
    __device__ __forceinline__ void operator()(const f32x4 (&acc)[2][2][4][2], const Unit& u, int wr, int wc, int fr, int fq) const {
        const int row0 = u.pm * BM + wr * 64 + fr; const int col0 = u.pn * BM + wc * 32 + 8 * fq;
#pragma unroll
        for (int ai = 0; ai < 2; ++ai) {
            u32x4 bb[4][2];
#pragma unroll
            for (int m = 0; m < 4; ++m)
#pragma unroll
                for (int bj = 0; bj < 2; ++bj) bb[m][bj] = *(const u32x4*)(hb + (size_t)(row0 + ai * HALF + m * 16) * ldc + col0 + bj * HALF);
#pragma unroll
            for (int m = 0; m < 4; ++m) { const int row = row0 + ai * HALF + m * 16; bf16_t* rowp = hb + (size_t)row * ldc + col0; float q = 0.f;
#pragma unroll
                for (int bj = 0; bj < 2; ++bj) { const u32x4 b = bb[m][bj]; f32x4 v0 = acc[ai][bj][m][0], v1 = acc[ai][bj][m][1];
                    v0[0] += __uint_as_float(b.x << 16); v0[1] += __uint_as_float(b.x & 0xffff0000u); v0[2] += __uint_as_float(b.y << 16); v0[3] += __uint_as_float(b.y & 0xffff0000u);
                    v1[0] += __uint_as_float(b.z << 16); v1[1] += __uint_as_float(b.z & 0xffff0000u); v1[2] += __uint_as_float(b.w << 16); v1[3] += __uint_as_float(b.w & 0xffff0000u);
                    q += ((v0[0] * v0[0] + v0[1] * v0[1]) + (v0[2] * v0[2] + v0[3] * v0[3])) + ((v1[0] * v1[0] + v1[1] * v1[1]) + (v1[2] * v1[2] + v1[3] * v1[3]));
                    u32x4 w; w.x = cvt_pk_bf16(v0[0], v0[1]); w.y = cvt_pk_bf16(v0[2], v0[3]); w.z = cvt_pk_bf16(v1[0], v1[1]); w.w = cvt_pk_bf16(v1[2], v1[3]);
                    *(u32x4*)(rowp + bj * HALF) = w; }
                q += __shfl_xor(q, 16); q += __shfl_xor(q, 32);
                if (fq == 0) ssq[(size_t)row * 16 + u.pn * 4 + wc] = q; }
        }
    }
    __device__ __forceinline__ void fused(f32x4 (&)[2][2][4][2], const Unit&, int, int, int, int, PG8_LAS unsigned char*, int, int) const {}
};
struct EpiAttIn {
    static constexpr bool PERM = true, AFTER_DRAIN = false;
    bf16_t* PROJ; bf16_t* VT; const float* ssq; const f32x2* r1; const f32x2* rr; const f32x2* rc; const float* qn; const float* kn;
    __device__ __forceinline__ void operator()(const f32x4 (&acc)[2][2][4][2], const Unit& u, int wr, int wc, int fr, int fq) const {
        const int pn = u.pn; const bool isB = pn >= 3; const int pt = isB ? pn - 3 : pn;
        const bool isQ = pt < 2, isV = (!isQ) && wc >= 2;
        const int row0 = u.pm * BM + wr * 64 + fr;
        const int dim0 = isB && !isV ? ((fq < 2) ? 8 * fq : 32 + 8 * (fq - 2)) : 8 * fq, dim1 = isB && !isV ? dim0 + 16 : 32 + 8 * fq;
        f32x4 g00 = {1.f, 1.f, 1.f, 1.f}, g01 = g00, g10 = g00, g11 = g00;
        if (isB && !isV) { const float* g = isQ ? qn : kn; g00 = *(const f32x4*)(g + dim0); g01 = *(const f32x4*)(g + dim0 + 4); g10 = *(const f32x4*)(g + dim1); g11 = *(const f32x4*)(g + dim1 + 4); }
        const int col = (isB ? 768 : 0) + (isQ ? 64 * (4 * pt + wc) : 512 + 64 * (wc & 1));
        f32x4 sv8[2][4]; float rs8[2][4];
#pragma unroll
        for (int ai = 0; ai < 2; ++ai)
#pragma unroll
            for (int m = 0; m < 4; ++m) sv8[ai][m] = *((const f32x4*)(ssq + (size_t)(row0 + ai * HALF + m * 16) * 16) + fq);
#pragma unroll
        for (int ai = 0; ai < 2; ++ai)
#pragma unroll
            for (int m = 0; m < 4; ++m) { float tot = (sv8[ai][m][0] + sv8[ai][m][1]) + (sv8[ai][m][2] + sv8[ai][m][3]); tot += __shfl_xor(tot, 16); tot += __shfl_xor(tot, 32);
                rs8[ai][m] = __builtin_amdgcn_rsqf(tot * (1.0f / 1024.0f) + 1e-6f); }
#pragma unroll
        for (int ai = 0; ai < 2; ++ai)
#pragma unroll
            for (int m = 0; m < 4; ++m) { const int row = row0 + ai * HALF + m * 16; const int pos = row & 8191;
                const float rs = rs8[ai][m];
                float x0[8], x1[8];
#pragma unroll
                for (int n = 0; n < 2; ++n)
#pragma unroll
                    for (int j = 0; j < 4; ++j) { x0[4 * n + j] = acc[ai][0][m][n][j] * rs; x1[4 * n + j] = acc[ai][1][m][n][j] * rs; }
                if (isV) {
                    const int b = row >> 13; bf16_t* vt = VT + ((size_t)(((b * 2 + (isB ? 1 : 0)) * 2 + (wc & 1)) * 64)) * 8192 + pos;
#pragma unroll
                    for (int e = 0; e < 8; e += 2) { const unsigned w0 = cvt_pk_bf16(x0[e], x0[e + 1]), w1 = cvt_pk_bf16(x1[e], x1[e + 1]);
                        vt[(size_t)(8 * fq + e) * 8192] = (bf16_t)(w0 & 0xffff); vt[(size_t)(8 * fq + e + 1) * 8192] = (bf16_t)(w0 >> 16);
                        vt[(size_t)(32 + 8 * fq + e) * 8192] = (bf16_t)(w1 & 0xffff); vt[(size_t)(32 + 8 * fq + e + 1) * 8192] = (bf16_t)(w1 >> 16); }
                } else {
                    const f32x2* tab;
                    if (isB) {
                        float ss = 0.f;
#pragma unroll
                        for (int e = 0; e < 8; ++e) ss += x0[e] * x0[e] + x1[e] * x1[e];
                        ss += __shfl_xor(ss, 16); ss += __shfl_xor(ss, 32);
                        const float hn = __builtin_amdgcn_rsqf(ss * (1.0f / 64.0f) + 1e-6f);
#pragma unroll
                        for (int e = 0; e < 4; ++e) { x0[e] *= hn * g00[e]; x0[4 + e] *= hn * g01[e]; x1[e] *= hn * g10[e]; x1[4 + e] *= hn * g11[e]; }
                        tab = (fq < 2) ? rr + (pos >> 6) * 16 + 8 * (fq & 1) : rc + (pos & 63) * 16 + 8 * (fq & 1);
                    } else tab = r1 + pos * 32 + 8 * fq;
                    const float qs = isQ ? 0.125f * 1.4426950408889634f : 1.0f;
                    float y0[8], y1[8];
#pragma unroll
                    for (int e = 0; e < 8; ++e) { const f32x2 cs = tab[e]; y0[e] = (x0[e] * cs.x - x1[e] * cs.y) * qs; y1[e] = (x1[e] * cs.x + x0[e] * cs.y) * qs; }
                    bf16_t* rowp = PROJ + (size_t)row * 1536 + col;
                    u32x4 w; w.x = cvt_pk_bf16(y0[0], y0[1]); w.y = cvt_pk_bf16(y0[2], y0[3]); w.z = cvt_pk_bf16(y0[4], y0[5]); w.w = cvt_pk_bf16(y0[6], y0[7]);
                    *(u32x4*)(rowp + dim0) = w;
                    w.x = cvt_pk_bf16(y1[0], y1[1]); w.y = cvt_pk_bf16(y1[2], y1[3]); w.z = cvt_pk_bf16(y1[4], y1[5]); w.w = cvt_pk_bf16(y1[6], y1[7]);
                    *(u32x4*)(rowp + dim1) = w;
                } }
    }
    __device__ __forceinline__ void fused(f32x4 (&)[2][2][4][2], const Unit&, int, int, int, int, PG8_LAS unsigned char*, int, int) const {}
};
template <class Epi, class Sched, bool ALIGN_EPI = false, bool SP2 = false>
__device__ __forceinline__ void gemm_phase(PG8_LAS unsigned char* lds, const Gemm g, const Sched& S, const Epi& E) {
    int tid_ = threadIdx.x; asm volatile("" : "+v"(tid_)); const int tid = tid_, wid = __builtin_amdgcn_readfirstlane(tid >> 6), lane = tid & 63, wr = wid >> 2, wc = wid & 3, fr = lane & 15, fq = lane >> 4;
    const int K = g.K, nt = K / BK;
    unsigned voffA[2], voffB[2];
#pragma unroll
    for (int i = 0; i < 2; ++i) { int R, C; stage_rc(tid * 16 + i * 8192, R, C); const int Rb = Epi::PERM ? ((R & ~31) + perm32(R & 31)) : R;
        voffA[i] = (unsigned)(R * K + C) * 2u; voffB[i] = (unsigned)(Rb * K + C) * 2u; }
    const size_t kstep = (size_t)(BK * 2);
    const size_t hstep = (size_t)HALF * K * 2;
    const size_t tstep = 2 * hstep;
    const unsigned ldsw = (unsigned)wid * 1024u;
    const int aoff = lds_byte(wr * 64 + fr, fq * 8), boff = lds_byte(wc * 32 + fr, fq * 8);
#define PG8_SA(b, h) (((b) * 2 + (h)) * HTB)
#define PG8_SB(b, h) ((4 + (b) * 2 + (h)) * HTB)
#define PG8_STAGE(bufoff, gbase, voff) do { _Pragma("unroll") for (int _i = 0; _i < 2; ++_i) \
        __builtin_amdgcn_global_load_lds((const unsigned*)((const char*)(gbase) + (voff)[_i]), (PG8_LAS unsigned*)(lds + (bufoff) + ldsw + _i * 8192), 16, 0, 0); } while (0)
#define PG8_LDA(dst, b, h) do { _Pragma("unroll") for (int m = 0; m < 4; ++m) _Pragma("unroll") for (int k = 0; k < 2; ++k) dst[m][k] = *(const PG8_LAS bf16x8*)(lds + PG8_SA(b, h) + aoff + m * 2048 + k * 1024); } while (0)
#define PG8_LDB(dst, b, h) do { _Pragma("unroll") for (int n = 0; n < 2; ++n) _Pragma("unroll") for (int k = 0; k < 2; ++k) dst[n][k] = *(const PG8_LAS bf16x8*)(lds + PG8_SB(b, h) + boff + n * 2048 + k * 1024); } while (0)
#define PG8_MMA(ai, bj, At, Bt) do { __builtin_amdgcn_s_setprio(1); _Pragma("unroll") for (int m = 0; m < 4; ++m) _Pragma("unroll") for (int n = 0; n < 2; ++n) _Pragma("unroll") for (int k = 0; k < 2; ++k) \
        acc[ai][bj][m][n] = __builtin_amdgcn_mfma_f32_16x16x32_bf16(Bt[n][k], At[m][k], acc[ai][bj][m][n], 0, 0, 0); __builtin_amdgcn_s_setprio(0); } while (0)
#define PG8_WAIT_V(n) asm volatile("s_waitcnt vmcnt(" #n ")" ::: "memory")
#define PG8_WAIT_L(n) asm volatile("s_waitcnt lgkmcnt(" #n ")" ::: "memory")
#define PG8_BAR __builtin_amdgcn_s_barrier()
#define PG8_SCHED __builtin_amdgcn_sched_barrier(0)
    Unit cur, nxt; int ui = 0;
    if (!S.next(0, cur)) return;
    f32x4 acc[2][2][4][2];
#pragma unroll
    for (int a = 0; a < 2; ++a)
#pragma unroll
        for (int b = 0; b < 2; ++b)
#pragma unroll
            for (int m = 0; m < 4; ++m)
#pragma unroll
                for (int n = 0; n < 2; ++n) acc[a][b][m][n] = (f32x4){0.f, 0.f, 0.f, 0.f};
    bf16x8 At[4][2], B0[2][2], B1[2][2];
    const char* cA = (const char*)g.A + (size_t)cur.pm * tstep; const char* cB = (const char*)g.Bt + (size_t)cur.pn * tstep;
    S.a_ready(cur);
    if constexpr (SP2) {
        PG8_STAGE(PG8_SB(0, 0), cB, voffB); PG8_STAGE(PG8_SB(0, 1), cB + hstep, voffB); PG8_STAGE(PG8_SA(0, 0), cA, voffA); PG8_STAGE(PG8_SA(0, 1), cA + hstep, voffA);
        if (wr == 1) PG8_BAR;
        PG8_WAIT_V(2); PG8_BAR;
        PG8_STAGE(PG8_SB(1, 0), cB + kstep, voffB); PG8_STAGE(PG8_SA(1, 0), cA + kstep, voffA); PG8_STAGE(PG8_SB(1, 1), cB + hstep + kstep, voffB);
        PG8_WAIT_V(6); PG8_BAR;
    } else {
        PG8_STAGE(PG8_SB(0, 0), cB, voffB); PG8_STAGE(PG8_SA(0, 0), cA, voffA); PG8_STAGE(PG8_SB(0, 1), cB + hstep, voffB); PG8_STAGE(PG8_SA(0, 1), cA + hstep, voffA);
        if (wr == 1) PG8_BAR;
        PG8_WAIT_V(4); PG8_BAR;
        PG8_STAGE(PG8_SB(1, 0), cB + kstep, voffB); PG8_STAGE(PG8_SA(1, 0), cA + kstep, voffA); PG8_STAGE(PG8_SB(1, 1), cB + hstep + kstep, voffB);
        PG8_WAIT_V(6); PG8_BAR;
    }
    for (;;) {
        const bool has_next = S.next(ui + 1, nxt);
        const char* nA = has_next ? (const char*)g.A + (size_t)nxt.pm * tstep : cA; const char* nB = has_next ? (const char*)g.Bt + (size_t)nxt.pn * tstep : cB;
        for (int t = 0; t < nt; t += 2) {
            const bool last = (t == nt - 2);
            const char* a1 = cA + (size_t)(t + 1) * kstep;
            const char* a2 = last ? nA : cA + (size_t)(t + 2) * kstep; const char* b2 = last ? nB : cB + (size_t)(t + 2) * kstep;
            const char* a3 = a2 + kstep; const char* b3 = b2 + kstep;
            if (last && has_next) S.a_ready(nxt);
            if constexpr (SP2) {
            PG8_LDB(B0, 0, 0); PG8_LDB(B1, 0, 1); PG8_SCHED; PG8_LDA(At, 0, 0); PG8_STAGE(PG8_SA(1, 1), a1 + hstep, voffA);
            PG8_WAIT_V(8); PG8_WAIT_L(0); PG8_BAR; PG8_MMA(0, 0, At, B0); PG8_MMA(0, 1, At, B1); PG8_BAR; PG8_SCHED;
            PG8_LDA(At, 0, 1); PG8_STAGE(PG8_SB(0, 0), b2, voffB); PG8_STAGE(PG8_SB(0, 1), b2 + hstep, voffB); PG8_STAGE(PG8_SA(0, 0), a2, voffA);
            PG8_WAIT_V(8); PG8_WAIT_L(0); PG8_BAR; PG8_MMA(1, 0, At, B0); PG8_MMA(1, 1, At, B1); PG8_BAR; PG8_SCHED;
            PG8_LDB(B0, 1, 0); PG8_LDB(B1, 1, 1); PG8_SCHED; PG8_LDA(At, 1, 0); PG8_STAGE(PG8_SA(0, 1), a2 + hstep, voffA);
            PG8_WAIT_V(8); PG8_WAIT_L(0); PG8_BAR; PG8_MMA(0, 0, At, B0); PG8_MMA(0, 1, At, B1); PG8_BAR; PG8_SCHED;
            PG8_LDA(At, 1, 1); PG8_STAGE(PG8_SB(1, 0), b3, voffB); PG8_STAGE(PG8_SB(1, 1), b3 + hstep, voffB); PG8_STAGE(PG8_SA(1, 0), a3, voffA);
            PG8_WAIT_V(8); PG8_WAIT_L(0); PG8_BAR; PG8_MMA(1, 0, At, B0); PG8_MMA(1, 1, At, B1); PG8_BAR; PG8_SCHED;
            } else {
            PG8_LDB(B0, 0, 0); PG8_SCHED; PG8_LDA(At, 0, 0); PG8_STAGE(PG8_SA(1, 1), a1 + hstep, voffA);
            PG8_WAIT_L(8); PG8_BAR; PG8_WAIT_L(0); PG8_MMA(0, 0, At, B0); PG8_BAR; PG8_SCHED;
            PG8_LDB(B1, 0, 1); PG8_STAGE(PG8_SB(0, 0), b2, voffB);
            PG8_BAR; PG8_WAIT_L(0); PG8_MMA(0, 1, At, B1); PG8_BAR;
            PG8_LDA(At, 0, 1); PG8_STAGE(PG8_SA(0, 0), a2, voffA);
            PG8_BAR; PG8_WAIT_L(0); PG8_MMA(1, 0, At, B0); PG8_BAR; PG8_SCHED;
            PG8_STAGE(PG8_SB(0, 1), b2 + hstep, voffB);
            PG8_WAIT_V(6); PG8_BAR; PG8_MMA(1, 1, At, B1); PG8_BAR;
            PG8_LDB(B0, 1, 0); PG8_SCHED; PG8_LDA(At, 1, 0); PG8_STAGE(PG8_SA(0, 1), a2 + hstep, voffA);
            PG8_WAIT_L(8); PG8_BAR; PG8_WAIT_L(0); PG8_MMA(0, 0, At, B0); PG8_BAR; PG8_SCHED;
            PG8_LDB(B1, 1, 1); PG8_STAGE(PG8_SB(1, 0), b3, voffB);
            PG8_BAR; PG8_WAIT_L(0); PG8_MMA(0, 1, At, B1); PG8_BAR;
            PG8_LDA(At, 1, 1); PG8_STAGE(PG8_SA(1, 0), a3, voffA);
            PG8_BAR; PG8_WAIT_L(0); PG8_MMA(1, 0, At, B0); PG8_BAR; PG8_SCHED;
            PG8_STAGE(PG8_SB(1, 1), b3 + hstep, voffB);
            PG8_WAIT_V(6); PG8_BAR; PG8_MMA(1, 1, At, B1); PG8_BAR;
            }
        }
        if constexpr (ALIGN_EPI) { if (wr == 0) PG8_BAR; }
        if constexpr (!Epi::AFTER_DRAIN) { E(acc, cur, wr, wc, fr, fq); S.done(cur); }
        if (!has_next) break;
#pragma unroll
        for (int a = 0; a < 2; ++a)
#pragma unroll
            for (int b = 0; b < 2; ++b)
#pragma unroll
                for (int m = 0; m < 4; ++m)
#pragma unroll
                    for (int n = 0; n < 2; ++n) acc[a][b][m][n] = (f32x4){0.f, 0.f, 0.f, 0.f};
        cur = nxt; cA = nA; cB = nB; ++ui;
        if constexpr (ALIGN_EPI) { if (wr == 1) PG8_BAR; }
    }
    PG8_WAIT_V(0);
    if constexpr (!ALIGN_EPI) { if (wr == 0) PG8_BAR; }
    PG8_BAR;
    if constexpr (Epi::AFTER_DRAIN) { E.fused(acc, cur, wr, wc, fr, fq, lds, wid, lane); S.done(cur); }
#undef PG8_SA
#undef PG8_SB
#undef PG8_STAGE
#undef PG8_LDA
#undef PG8_LDB
#undef PG8_MMA
#undef PG8_WAIT_V
#undef PG8_WAIT_L
#undef PG8_BAR
#undef PG8_SCHED
}
}
typedef unsigned short bf16_t;
typedef short bf16x8 __attribute__((ext_vector_type(8)));
typedef float f32x4 __attribute__((ext_vector_type(4)));
typedef float f32x16 __attribute__((ext_vector_type(16)));
typedef unsigned u32x4 __attribute__((ext_vector_type(4)));
typedef unsigned u32x2 __attribute__((ext_vector_type(2)));
typedef float f32x2_t __attribute__((ext_vector_type(2)));
typedef __bf16 bf16x2_t __attribute__((ext_vector_type(2)));

constexpr int D = 1024, BATCH = 4, SEQ = 8192, M = BATCH * SEQ, DFF = 4096, ATT_IN = 1536, SGU_IN = 2048, DEPTH = 4;
constexpr float EPS = 1e-6f, LOG2E = 1.4426950408889634f, QSCALE = 0.125f * 1.4426950408889634f;
constexpr size_t MiB = 1u << 20;
constexpr size_t WS_CTL = 0;
constexpr size_t WS_ROPE1 = 1 * MiB, WS_ROPER = 3 * MiB, WS_ROPEC = 3 * MiB + 16384, WS_WS = 3 * MiB + 512 * 1024;
constexpr size_t WS_WATT_IN = 4 * MiB, WS_WATT_OUT = 10 * MiB, WS_WSGU_IN = 14 * MiB, WS_WSGU_OUT = 22 * MiB, WS_W1 = 26 * MiB, WS_W2 = 58 * MiB;
constexpr size_t WS_XN = 90 * MiB, WS_BIG = 154 * MiB, WS_SSQ2 = 410 * MiB, WS_END = 412 * MiB;
constexpr size_t BIG_PROJ = 0, BIG_O = 96 * MiB, BIG_VT = 160 * MiB, BIG_Z = 0, BIG_Y = 128 * MiB, BIG_HID = 0;
constexpr int LDS_BYTES = 131072 + 2048;
constexpr int NPHASE = 34;

struct Params { const float* in[18]; float* out; unsigned char* ws; int ph_lo, ph_hi; };

__device__ __forceinline__ unsigned pk2(float lo, float hi) { f32x2_t v = {lo, hi}; bf16x2_t b = __builtin_convertvector(v, bf16x2_t); return __builtin_bit_cast(unsigned, b); }
__device__ __forceinline__ float bf_lo(unsigned w) { return __uint_as_float(w << 16); }
__device__ __forceinline__ float bf_hi(unsigned w) { return __uint_as_float(w & 0xffff0000u); }
__device__ __forceinline__ float bf1(bf16_t h) { return __uint_as_float(((unsigned)h) << 16); }
__device__ __forceinline__ float wave_sum(float v) {
#pragma unroll
    for (int o = 1; o < 64; o <<= 1) v += __shfl_xor(v, o);
    return v;
}
#define MFMA32(a, b, c) __builtin_amdgcn_mfma_f32_32x32x16_bf16((a), (b), (c), 0, 0, 0)

__device__ __forceinline__ int att_remap(int n) {
    const int pn = n >> 8, hq = (n >> 6) & 3, dl = n & 63; int bj, s;
    if (pn >= 3 && !(pn == 5 && hq >= 2)) { if (dl < 16) { bj = 0; s = dl; } else if (dl < 32) { bj = 1; s = dl - 16; } else if (dl < 48) { bj = 0; s = dl - 16; } else { bj = 1; s = dl - 32; } }
    else { bj = dl >> 5; s = dl & 31; }
    return 256 * pn + 128 * bj + 32 * hq + s;
}
__device__ __forceinline__ void transpose_load(float (&v)[32], const float* W, int N, int item, int lane) {
    const int nblk = N / 32, kb = item / nblk, nb = item % nblk, k0 = 64 * kb, n0 = 32 * nb;
    const float* src = W + (size_t)(k0 + (lane >> 5)) * N + n0 + (lane & 31);
#pragma unroll
    for (int i = 0; i < 32; ++i) v[i] = src[(size_t)(2 * i) * N];
}
__device__ __forceinline__ void transpose_store(const float (&v)[32], int K, int N, const float* gain, bf16_t* WT, float* scr, int item, int lane, bool remap) {
    const int nblk = N / 32, kb = item / nblk, nb = item % nblk, k0 = 64 * kb, n0 = 32 * nb;
    const int c = lane & 7;
    f32x4 g0 = {1.f, 1.f, 1.f, 1.f}, g1 = g0;
    if (gain) { g0 = *(const f32x4*)(gain + k0 + 8 * c); g1 = *(const f32x4*)(gain + k0 + 8 * c + 4); }
#pragma unroll
    for (int i = 0; i < 32; ++i) scr[(2 * i + (lane >> 5)) * 33 + (lane & 31)] = v[i];
    asm volatile("s_waitcnt lgkmcnt(0)" ::: "memory");
#pragma unroll
    for (int j = 0; j < 4; ++j) { const int n = (lane >> 3) + 8 * j; const float* s = scr + (8 * c) * 33 + n;
        u32x4 o; o.x = pk2(s[0 * 33] * g0[0], s[1 * 33] * g0[1]); o.y = pk2(s[2 * 33] * g0[2], s[3 * 33] * g0[3]); o.z = pk2(s[4 * 33] * g1[0], s[5 * 33] * g1[1]); o.w = pk2(s[6 * 33] * g1[2], s[7 * 33] * g1[3]);
        const int nrow = remap ? att_remap(n0 + n) : n0 + n;
        *(u32x4*)(WT + (size_t)nrow * K + k0 + 8 * c) = o; }
    asm volatile("s_waitcnt lgkmcnt(0)" ::: "memory");
}
__device__ __forceinline__ void phase_prologue(const Params& p, unsigned char* lds) {
    int tid_ = threadIdx.x; asm volatile("" : "+v"(tid_)); const int tid = tid_, lane = tid & 63, wave = tid >> 6;
    const int gw = blockIdx.x * 8 + wave, ngw = gridDim.x * 8;
    float* scr = (float*)(lds + wave * 16384);
    const int nmat = (gridDim.x == 256) ? 1 : 16;
    for (int mi = 0; mi < nmat; ++mi) {
        const float* W; const float* gain = nullptr; bf16_t* WT; int K = D, N;
        if (mi < 2)       { W = p.in[2] + (size_t)mi * D * ATT_IN; gain = p.in[1] + mi * D; N = ATT_IN; WT = (bf16_t*)(p.ws + WS_WATT_IN) + (size_t)mi * ATT_IN * D; }
        else if (mi < 4)  { const int i = mi - 2; W = p.in[6] + (size_t)i * D * D; N = D; WT = (bf16_t*)(p.ws + WS_WATT_OUT) + (size_t)i * D * D; }
        else if (mi < 6)  { const int i = mi - 4; W = p.in[8] + (size_t)i * D * SGU_IN; gain = p.in[7] + i * D; N = SGU_IN; WT = (bf16_t*)(p.ws + WS_WSGU_IN) + (size_t)i * SGU_IN * D; }
        else if (mi < 8)  { const int i = mi - 6; W = p.in[13] + (size_t)i * D * D; N = D; WT = (bf16_t*)(p.ws + WS_WSGU_OUT) + (size_t)i * D * D; }
        else if (mi < 12) { const int i = mi - 8; W = p.in[15] + (size_t)i * D * DFF; gain = p.in[14] + i * D; N = DFF; WT = (bf16_t*)(p.ws + WS_W1) + (size_t)i * DFF * D; }
        else              { const int i = mi - 12; W = p.in[16] + (size_t)i * DFF * D; K = DFF; N = D; WT = (bf16_t*)(p.ws + WS_W2) + (size_t)i * D * DFF; }
        const int items = (K / 64) * (N / 32);
        float va[32], vb[32];
        int it = gw;
        if (it < items) transpose_load(va, W, N, it, lane);
        for (; it < items; it += 2 * ngw) {
            const int it1 = it + ngw, it2 = it + 2 * ngw;
            if (it1 < items) transpose_load(vb, W, N, it1, lane);
            transpose_store(va, K, N, gain, WT, scr, it, lane, mi < 2);
            if (it2 < items) transpose_load(va, W, N, it2, lane);
            if (it1 < items) transpose_store(vb, K, N, gain, WT, scr, it1, lane, mi < 2);
        }
    }
    { const float* src = p.in[11]; bf16_t* dst = (bf16_t*)(p.ws + WS_WS); const int n4 = 2 * 8 * 128 * 128 / 4;
      for (int i = blockIdx.x * 512 + tid; i < n4; i += gridDim.x * 512) { const f32x4 v = *(const f32x4*)(src + 4 * (size_t)i); u32x2 o; o.x = pk2(v[0], v[1]); o.y = pk2(v[2], v[3]); *(u32x2*)(dst + 4 * (size_t)i) = o; } }
    { f32x2_t* r1 = (f32x2_t*)(p.ws + WS_ROPE1); f32x2_t* rr = (f32x2_t*)(p.ws + WS_ROPER); f32x2_t* rc = (f32x2_t*)(p.ws + WS_ROPEC);
      const int total = SEQ * 32 + 128 * 16 + 64 * 16;
      for (int i = blockIdx.x * 512 + tid; i < total; i += gridDim.x * 512) {
          int pos, fi; float fexp; f32x2_t* dst;
          if (i < SEQ * 32) { pos = i >> 5; fi = i & 31; fexp = (float)fi * (1.0f / 32.0f); dst = r1 + i; }
          else if (i < SEQ * 32 + 128 * 16) { const int j = i - SEQ * 32; pos = j >> 4; fi = j & 15; fexp = (float)fi * (1.0f / 16.0f); dst = rr + j; }
          else { const int j = i - SEQ * 32 - 128 * 16; pos = j >> 4; fi = j & 15; fexp = (float)fi * (1.0f / 16.0f); dst = rc + j; }
          const float freq = exp2f(-fexp * 13.287712379549449f);
          const float ang = (float)pos * freq;
          float tr = ang * 0.15915494309189535f; tr = tr - floorf(tr);
          const float sn = __builtin_amdgcn_sinf(tr), cs = __builtin_amdgcn_cosf(tr);
          *dst = (f32x2_t){cs, sn};
      } }
}

constexpr int DEFER_TOTAL = 512 + 2048 + 2048 + 1024 + 512 + 2048 + 2048 + 768 + 512 + 2048 + 2048 + 1024 + 512 + 2048 + 2048;
__device__ __forceinline__ void deferred_convert_item(const Params& p, int g, unsigned char* lds, int wave, int lane) {
    if (g >= DEFER_TOTAL) return;
    const float* W; const float* gain = nullptr; bf16_t* WT; int K = D, N = D; bool remap = false; int r = g;
    int kind, idx;
    if (r < 512) { kind = 0; idx = 0; } else if ((r -= 512) < 2048) { kind = 1; idx = 0; } else if ((r -= 2048) < 2048) { kind = 2; idx = 0; }
    else if ((r -= 2048) < 1024) { kind = 3; idx = 0; } else if ((r -= 1024) < 512) { kind = 4; idx = 0; } else if ((r -= 512) < 2048) { kind = 1; idx = 1; }
    else if ((r -= 2048) < 2048) { kind = 2; idx = 1; } else if ((r -= 2048) < 768) { kind = 5; idx = 1; } else if ((r -= 768) < 512) { kind = 0; idx = 1; }
    else if ((r -= 512) < 2048) { kind = 1; idx = 2; } else if ((r -= 2048) < 2048) { kind = 2; idx = 2; } else if ((r -= 2048) < 1024) { kind = 3; idx = 1; }
    else if ((r -= 1024) < 512) { kind = 4; idx = 1; } else if ((r -= 512) < 2048) { kind = 1; idx = 3; } else { r -= 2048; kind = 2; idx = 3; }
    if (kind == 0)      { W = p.in[6] + (size_t)idx * D * D; WT = (bf16_t*)(p.ws + WS_WATT_OUT) + (size_t)idx * D * D; }
    else if (kind == 1) { W = p.in[15] + (size_t)idx * D * DFF; gain = p.in[14] + idx * D; N = DFF; WT = (bf16_t*)(p.ws + WS_W1) + (size_t)idx * DFF * D; }
    else if (kind == 2) { W = p.in[16] + (size_t)idx * DFF * D; K = DFF; WT = (bf16_t*)(p.ws + WS_W2) + (size_t)idx * D * DFF; }
    else if (kind == 3) { W = p.in[8] + (size_t)idx * D * SGU_IN; gain = p.in[7] + idx * D; N = SGU_IN; WT = (bf16_t*)(p.ws + WS_WSGU_IN) + (size_t)idx * SGU_IN * D; }
    else if (kind == 4) { W = p.in[13] + (size_t)idx * D * D; WT = (bf16_t*)(p.ws + WS_WSGU_OUT) + (size_t)idx * D * D; }
    else                { W = p.in[2] + (size_t)idx * D * ATT_IN; gain = p.in[1] + idx * D; N = ATT_IN; WT = (bf16_t*)(p.ws + WS_WATT_IN) + (size_t)idx * ATT_IN * D; remap = true; }
    float v[32];
    transpose_load(v, W, N, r, lane);
    transpose_store(v, K, N, gain, WT, (float*)(lds + wave * 16384), r, lane, remap);
}
__device__ __forceinline__ void phase_cast_x(const float* src, bf16_t* dst, float* ssq) {
    int tid_ = threadIdx.x; asm volatile("" : "+v"(tid_)); const int tid = tid_, lane = tid & 63, wave = tid >> 6;
    const int gw = blockIdx.x * 8 + wave, ngw = gridDim.x * 8;
    for (int m0 = gw; m0 < M; m0 += 4 * ngw) {
        f32x4 v[4][4];
#pragma unroll
        for (int rr = 0; rr < 4; ++rr) { const int m = m0 + rr * ngw; if (m < M) { const f32x4* xr = (const f32x4*)(src + (size_t)m * D) + lane;
#pragma unroll
            for (int j = 0; j < 4; ++j) v[rr][j] = xr[64 * j]; } }
#pragma unroll
        for (int rr = 0; rr < 4; ++rr) { const int m = m0 + rr * ngw; if (m < M) { float s = 0.f;
#pragma unroll
            for (int j = 0; j < 4; ++j) s += (v[rr][j][0] * v[rr][j][0] + v[rr][j][1] * v[rr][j][1]) + (v[rr][j][2] * v[rr][j][2] + v[rr][j][3] * v[rr][j][3]);
            s = wave_sum(s);
            u32x2* o8 = (u32x2*)(dst + (size_t)m * D) + lane;
#pragma unroll
            for (int j = 0; j < 4; ++j) { u32x2 o; o.x = pk2(v[rr][j][0], v[rr][j][1]); o.y = pk2(v[rr][j][2], v[rr][j][3]); o8[64 * j] = o; }
            if (lane < 16) ssq[(size_t)m * 16 + lane] = lane == 0 ? s : 0.f; } }
    }
}
__device__ __forceinline__ void phase_norm(const float* src, bf16_t* dst) {
    int tid_ = threadIdx.x; asm volatile("" : "+v"(tid_)); const int tid = tid_, lane = tid & 63, wave = tid >> 6;
    const int gw = blockIdx.x * 8 + wave, ngw = gridDim.x * 8;
    for (int m = gw; m < M; m += ngw) {
        const f32x4* xr = (const f32x4*)(src + (size_t)m * D) + lane;
        f32x4 v[4]; float s = 0.f;
#pragma unroll
        for (int j = 0; j < 4; ++j) { v[j] = xr[64 * j]; s += (v[j][0] * v[j][0] + v[j][1] * v[j][1]) + (v[j][2] * v[j][2] + v[j][3] * v[j][3]); }
        const float rs = rsqrtf(wave_sum(s) * (1.0f / D) + EPS);
        u32x2* o8 = (u32x2*)(dst + (size_t)m * D) + lane;
#pragma unroll
        for (int j = 0; j < 4; ++j) { u32x2 o; o.x = pk2(v[j][0] * rs, v[j][1] * rs); o.y = pk2(v[j][2] * rs, v[j][3] * rs); o8[64 * j] = o; }
    }
}
__device__ __forceinline__ void phase_final_norm(const bf16_t* hb, float* out, const float* g) {
    int tid_ = threadIdx.x; asm volatile("" : "+v"(tid_)); const int tid = tid_, lane = tid & 63, wave = tid >> 6;
    const int gw = blockIdx.x * 8 + wave, ngw = gridDim.x * 8;
    f32x4 gg[4];
#pragma unroll
    for (int j = 0; j < 4; ++j) gg[j] = *((const f32x4*)g + lane + 64 * j);
    for (int m0 = gw; m0 < M; m0 += 4 * ngw) {
        u32x2 raw[4][4];
#pragma unroll
        for (int rr = 0; rr < 4; ++rr) { const int m = m0 + rr * ngw; if (m < M) { const u32x2* xr = (const u32x2*)(hb + (size_t)m * D) + lane;
#pragma unroll
            for (int j = 0; j < 4; ++j) raw[rr][j] = xr[64 * j]; } }
#pragma unroll
        for (int rr = 0; rr < 4; ++rr) { const int m = m0 + rr * ngw; if (m < M) { f32x4 v[4]; float s = 0.f;
#pragma unroll
            for (int j = 0; j < 4; ++j) { const u32x2 r = raw[rr][j]; v[j] = (f32x4){bf_lo(r.x), bf_hi(r.x), bf_lo(r.y), bf_hi(r.y)}; s += (v[j][0] * v[j][0] + v[j][1] * v[j][1]) + (v[j][2] * v[j][2] + v[j][3] * v[j][3]); }
            const float rs = rsqrtf(wave_sum(s) * (1.0f / D) + EPS);
            f32x4* o = (f32x4*)(out + (size_t)m * D) + lane;
#pragma unroll
            for (int j = 0; j < 4; ++j) o[64 * j] = v[j] * rs * gg[j]; } }
    }
}

__device__ __forceinline__ void phase_prep(const Params& p, int li) {
    int tid_ = threadIdx.x; asm volatile("" : "+v"(tid_)); const int tid = tid_, lane = tid & 63, wave = tid >> 6;
    bf16_t* PROJ = (bf16_t*)(p.ws + WS_BIG + BIG_PROJ); bf16_t* VT = (bf16_t*)(p.ws + WS_BIG + BIG_VT);
    const f32x2_t* r1 = (const f32x2_t*)(p.ws + WS_ROPE1); const f32x2_t* rr = (const f32x2_t*)(p.ws + WS_ROPER); const f32x2_t* rc = (const f32x2_t*)(p.ws + WS_ROPEC);
    const float* qn = p.in[4] + li * 64; const float* kn = p.in[5] + li * 64;
    for (int tt = blockIdx.x; tt < M / 64; tt += gridDim.x) {
        const int b = tt >> 7, s0 = (tt & 127) * 64;
        const int tok = tid >> 3, j = tid & 7; const int pos = s0 + tok; const size_t row = (size_t)tt * 64 + tok;
#pragma unroll 5
        for (int hs = 0; hs < 20; ++hs) {
            const bool isB = hs >= 10; const int h2 = isB ? hs - 10 : hs; const bool isQ = h2 < 8;
            const int col = (isB ? 768 : 0) + (isQ ? 64 * h2 : 512 + 64 * (h2 - 8));
            bf16_t* ptr = PROJ + row * ATT_IN + col + 8 * j;
            const u32x4 raw = *(const u32x4*)ptr;
            float x[8]; x[0] = bf_lo(raw.x); x[1] = bf_hi(raw.x); x[2] = bf_lo(raw.y); x[3] = bf_hi(raw.y); x[4] = bf_lo(raw.z); x[5] = bf_hi(raw.z); x[6] = bf_lo(raw.w); x[7] = bf_hi(raw.w);
            float y[8];
            if (!isB) {
#pragma unroll
                for (int e = 0; e < 8; ++e) { const float pr = __shfl_xor(x[e], 4); const f32x2_t cs = r1[pos * 32 + 8 * (j & 3) + e]; y[e] = x[e] * cs.x + ((j < 4) ? -pr : pr) * cs.y; }
            } else {
                float ss = 0.f;
#pragma unroll
                for (int e = 0; e < 8; ++e) ss += x[e] * x[e];
                ss += __shfl_xor(ss, 1); ss += __shfl_xor(ss, 2); ss += __shfl_xor(ss, 4);
                const float rs = rsqrtf(ss * (1.0f / 64.0f) + EPS); const float* gn = isQ ? qn : kn;
#pragma unroll
                for (int e = 0; e < 8; ++e) x[e] = x[e] * rs * gn[8 * j + e];
                const f32x2_t* tab = (j < 4) ? (rr + (pos >> 6) * 16) : (rc + (pos & 63) * 16);
#pragma unroll
                for (int e = 0; e < 8; ++e) { const float pr = __shfl_xor(x[e], 2); const f32x2_t cs = tab[8 * (j & 1) + e]; y[e] = x[e] * cs.x + ((j & 2) ? pr : -pr) * cs.y; }
            }
            if (isQ) {
#pragma unroll
                for (int e = 0; e < 8; ++e) y[e] *= QSCALE;
            }
            u32x4 o; o.x = pk2(y[0], y[1]); o.y = pk2(y[2], y[3]); o.z = pk2(y[4], y[5]); o.w = pk2(y[6], y[7]);
            *(u32x4*)ptr = o;
        }
#pragma unroll
        for (int i = 0; i < 4; ++i) {
            const int vcol = (wave * 4 + i) * 8; const int type = vcol >> 7, kvh = (vcol >> 6) & 1, d0 = vcol & 63;
            const int col = (type ? 1408 : 640) + kvh * 64 + d0;
            const u32x4 raw = *(const u32x4*)(PROJ + ((size_t)tt * 64 + lane) * ATT_IN + col);
            bf16_t* vt = VT + ((size_t)(((b * 2 + type) * 2 + kvh) * 64 + d0)) * SEQ + s0 + lane;
            vt[0 * SEQ] = (bf16_t)(raw.x & 0xffff); vt[1 * SEQ] = (bf16_t)(raw.x >> 16); vt[2 * SEQ] = (bf16_t)(raw.y & 0xffff); vt[3 * SEQ] = (bf16_t)(raw.y >> 16);
            vt[4 * SEQ] = (bf16_t)(raw.z & 0xffff); vt[5 * SEQ] = (bf16_t)(raw.z >> 16); vt[6 * SEQ] = (bf16_t)(raw.w & 0xffff); vt[7 * SEQ] = (bf16_t)(raw.w >> 16);
        }
    }
}

constexpr int KSTR = 144;
__device__ __forceinline__ float max3f(float a, float b, float c) { float r; asm("v_max3_f32 %0, %1, %2, %3" : "=v"(r) : "v"(a), "v"(b), "v"(c)); return r; }
__device__ __forceinline__ float max2f(float a, float b) { float r; asm("v_max_f32_e32 %0, %1, %2" : "=v"(r) : "v"(a), "v"(b)); return r; }
constexpr float ATT_THR = 10.0f;
__device__ __forceinline__ void qk_tile(f32x16& p0, f32x16& p1, const unsigned char* kb, const bf16x8 (&qr)[4], float cinit) {
#pragma unroll
    for (int r = 0; r < 16; ++r) { p0[r] = cinit; p1[r] = cinit; }
#pragma unroll
    for (int d0 = 0; d0 < 4; ++d0) {
        const bf16x8 a0 = *(const bf16x8*)(kb + d0 * 32), a1 = *(const bf16x8*)(kb + 32 * KSTR + d0 * 32);
        p0 = MFMA32(a0, qr[d0], p0); p1 = MFMA32(a1, qr[d0], p1);
    }
}
__device__ __forceinline__ void band_mask(f32x16& p0, f32x16& p1, int kb0) {
#pragma unroll
    for (int r = 0; r < 16; ++r) { const int dk = kb0 + (r & 3) + 8 * (r >> 2);
        if (dk > 128 || dk < -128) p0[r] = -INFINITY;
        if (dk + 32 > 128 || dk + 32 < -128) p1[r] = -INFINITY; }
}
#define SGB(mask, n) __builtin_amdgcn_sched_group_barrier(mask, n, 0)
__device__ __forceinline__ float sum16(const f32x16& x) {
    float r;
    asm("s_nop 1\n\tv_add_f32_e32 %0, %1, %2\n\tv_add_f32_e32 %0, %0, %3\n\tv_add_f32_e32 %0, %0, %4\n\tv_add_f32_e32 %0, %0, %5\n\tv_add_f32_e32 %0, %0, %6\n\tv_add_f32_e32 %0, %0, %7\n\tv_add_f32_e32 %0, %0, %8\n\t"
        "v_add_f32_e32 %0, %0, %9\n\tv_add_f32_e32 %0, %0, %10\n\tv_add_f32_e32 %0, %0, %11\n\tv_add_f32_e32 %0, %0, %12\n\tv_add_f32_e32 %0, %0, %13\n\tv_add_f32_e32 %0, %0, %14\n\tv_add_f32_e32 %0, %0, %15\n\tv_add_f32_e32 %0, %0, %16"
        : "=&v"(r) : "v"(x[0]), "v"(x[1]), "v"(x[2]), "v"(x[3]), "v"(x[4]), "v"(x[5]), "v"(x[6]), "v"(x[7]), "v"(x[8]), "v"(x[9]), "v"(x[10]), "v"(x[11]), "v"(x[12]), "v"(x[13]), "v"(x[14]), "v"(x[15]));
    return r;
}
template <int TYPE>
__device__ __forceinline__ void attn_soft(f32x16& sA, f32x16& sB, int kb0, float& tsum, u32x4 (&pw)[4]) {
    if (TYPE == 0) band_mask(sA, sB, kb0);
#pragma unroll
    for (int r = 0; r < 16; ++r) { sA[r] = __builtin_amdgcn_exp2f(sA[r]); sB[r] = __builtin_amdgcn_exp2f(sB[r]); }
    tsum = sum16(sA) + sum16(sB);
#pragma unroll
    for (int s = 0; s < 2; ++s) {
        pw[s]     = (u32x4){pk2(sA[8 * s], sA[8 * s + 1]), pk2(sA[8 * s + 2], sA[8 * s + 3]), pk2(sA[8 * s + 4], sA[8 * s + 5]), pk2(sA[8 * s + 6], sA[8 * s + 7])};
        pw[2 + s] = (u32x4){pk2(sB[8 * s], sB[8 * s + 1]), pk2(sB[8 * s + 2], sB[8 * s + 3]), pk2(sB[8 * s + 4], sB[8 * s + 5]), pk2(sB[8 * s + 6], sB[8 * s + 7])};
    }
}
struct AttnState2 { float mrun[2]; float lrun[2]; f32x16 o[2][2]; };
template <int TYPE>
__device__ __forceinline__ void attn_step2(AttnState2& st, const bf16x8 (&qr)[2][4], const unsigned char* kb, const unsigned char* vb, int kb0) {
    bf16x8 kf[8];
#pragma unroll
    for (int d0 = 0; d0 < 4; ++d0) { kf[2 * d0] = *(const bf16x8*)(kb + d0 * 32); kf[2 * d0 + 1] = *(const bf16x8*)(kb + 32 * KSTR + d0 * 32); }
    __builtin_amdgcn_sched_barrier(0);
    f32x16 s00, s01, s10, s11;
    { f32x16 z, z1;
#pragma unroll
      for (int r = 0; r < 16; ++r) { z[r] = 0.f; z1[r] = 0.f; }
      s00 = MFMA32(kf[0], qr[0][0], z); s01 = MFMA32(kf[1], qr[0][0], z);
#pragma unroll
      for (int d0 = 1; d0 < 4; ++d0) { s00 = MFMA32(kf[2 * d0], qr[0][d0], s00); s01 = MFMA32(kf[2 * d0 + 1], qr[0][d0], s01); }
      s10 = MFMA32(kf[0], qr[1][0], z1); s11 = MFMA32(kf[1], qr[1][0], z1);
#pragma unroll
      for (int d0 = 1; d0 < 4; ++d0) { s10 = MFMA32(kf[2 * d0], qr[1][d0], s10); s11 = MFMA32(kf[2 * d0 + 1], qr[1][d0], s11); } }
    bf16x8 vf[8];
#pragma unroll
    for (int c = 0; c < 4; ++c) { vf[2 * c] = *(const bf16x8*)(vb + c * 32); vf[2 * c + 1] = *(const bf16x8*)(vb + 32 * KSTR + c * 32); }
    if (__any(st.mrun[0] != 0.0f || st.mrun[1] != 0.0f)) {
#pragma unroll
        for (int r = 0; r < 16; ++r) { s00[r] -= st.mrun[0]; s01[r] -= st.mrun[0]; s10[r] -= st.mrun[1]; s11[r] -= st.mrun[1]; }
    }
    float pm0, pm1; u32x4 pw0[4], pw1[4];
    attn_soft<TYPE>(s00, s01, kb0, pm0, pw0);
#pragma unroll
    for (int c = 0; c < 4; ++c) { const bf16x8 pf = __builtin_bit_cast(bf16x8, pw0[c]); st.o[0][0] = MFMA32(vf[2 * c], pf, st.o[0][0]); st.o[0][1] = MFMA32(vf[2 * c + 1], pf, st.o[0][1]); }
    attn_soft<TYPE>(s10, s11, kb0 - 32, pm1, pw1);
#pragma unroll
    for (int c = 0; c < 4; ++c) { const bf16x8 pf = __builtin_bit_cast(bf16x8, pw1[c]); st.o[1][0] = MFMA32(vf[2 * c], pf, st.o[1][0]); st.o[1][1] = MFMA32(vf[2 * c + 1], pf, st.o[1][1]); }
#pragma unroll
    for (int k = 0; k < 8; ++k) SGB(0x008, 1);
#pragma unroll
    for (int k = 0; k < 8; ++k) { SGB(0x008, 1); SGB(0x002, 6); }
    SGB(0x100, 8);
#pragma unroll
    for (int k = 0; k < 8; ++k) { SGB(0x008, 1); SGB(0x002, 8); }
    __builtin_amdgcn_sched_barrier(0);
    st.lrun[0] += pm0; st.lrun[1] += pm1;
    if (__any(pm0 > 1024.0f || pm1 > 1024.0f)) {
        const float r0 = pm0 + __shfl_xor(pm0, 32), r1 = pm1 + __shfl_xor(pm1, 32);
        const float d0 = r0 > 1024.0f ? __builtin_amdgcn_logf(r0) : 0.0f, d1 = r1 > 1024.0f ? __builtin_amdgcn_logf(r1) : 0.0f;
        const float a0 = __builtin_amdgcn_exp2f(-d0), a1 = __builtin_amdgcn_exp2f(-d1);
#pragma unroll
        for (int r = 0; r < 16; ++r) { st.o[0][0][r] *= a0; st.o[0][1][r] *= a0; st.o[1][0][r] *= a1; st.o[1][1][r] *= a1; }
        st.lrun[0] *= a0; st.lrun[1] *= a1; st.mrun[0] += d0; st.mrun[1] += d1;
    }
}
template <int TYPE>
__device__ __forceinline__ void attn_unit(unsigned char* lds, const bf16_t* PROJ, const bf16_t* VT, bf16_t* O, const float* sink, int b, int kvh, int qt) {
    constexpr int type = TYPE;
    int tid_ = threadIdx.x; asm volatile("" : "+v"(tid_)); const int tid = tid_, lane = tid & 63, w = tid >> 6, r32 = lane & 31, hi = lane >> 5;
    const int hg = w >> 1, rh = w & 1, qhead = kvh * 4 + hg;
    const int qcol = (type ? 768 : 0) + 64 * qhead, kcol = (type ? 1280 : 512) + 64 * kvh;
    const size_t rowbase = (size_t)b * SEQ;
    const int qpos0 = qt * 128 + 64 * rh + r32;
    bf16x8 qr[2][4];
#pragma unroll
    for (int blk = 0; blk < 2; ++blk) { const bf16_t* qp = PROJ + (rowbase + qpos0 + 32 * blk) * ATT_IN + qcol + 8 * hi;
#pragma unroll
      for (int d0 = 0; d0 < 4; ++d0) qr[blk][d0] = *(const bf16x8*)(qp + 16 * d0); }
    int t_lo = 0, t_hi = SEQ / 64 - 1;
    if (type == 0) { t_lo = 2 * qt - 2 < 0 ? 0 : 2 * qt - 2; t_hi = 2 * qt + 3 > SEQ / 64 - 1 ? SEQ / 64 - 1 : 2 * qt + 3; }
    const int n = t_hi - t_lo + 1;
    const int srow = tid >> 3, sch = tid & 7;
    const bf16_t* kg = PROJ + (rowbase + (size_t)t_lo * 64 + srow) * ATT_IN + kcol + 8 * sch;
    const bf16_t* vg = VT + ((size_t)(((b * 2 + type) * 2 + kvh) * 64 + srow)) * SEQ + t_lo * 64 + 8 * sch;
    unsigned char* Ks = lds; unsigned char* Vs = lds + 2 * 64 * KSTR;
    const int ksoff = srow * KSTR + sch * 16;
    const int vsoff = srow * KSTR + (sch >> 1) * 32 + (sch & 1) * 8;
    const int foff = r32 * KSTR + hi * 16;
    { const u32x4 k0 = *(const u32x4*)kg, v0 = *(const u32x4*)vg;
      *(u32x4*)(Ks + ksoff) = k0; *(u32x2*)(Vs + vsoff) = (u32x2){v0.x, v0.y}; *(u32x2*)(Vs + vsoff + 16) = (u32x2){v0.z, v0.w}; }
    __syncthreads();
    AttnState2 st;
    const float l0 = (type == 0 && hi == 0) ? __builtin_amdgcn_exp2f(sink[qhead] * LOG2E) : 0.0f;
#pragma unroll
    for (int blk = 0; blk < 2; ++blk) { st.mrun[blk] = 0.0f; st.lrun[blk] = l0;
#pragma unroll
        for (int r = 0; r < 16; ++r) { st.o[blk][0][r] = 0.f; st.o[blk][1][r] = 0.f; } }
    for (int i = 0; i < n; ++i) {
        u32x4 kreg, vreg;
        { const int i1 = i + 1 < n ? i + 1 : i; kreg = *(const u32x4*)(kg + (size_t)i1 * 64 * ATT_IN); vreg = *(const u32x4*)(vg + i1 * 64); }
        const unsigned char* kb = Ks + (i & 1) * 64 * KSTR + foff; const unsigned char* vb = Vs + (i & 1) * 64 * KSTR + foff;
        const int kb0 = (t_lo + i) * 64 + 4 * hi - qpos0;
        attn_step2<TYPE>(st, qr, kb, vb, kb0);
        { const int nb = ((i + 1) & 1) * 64 * KSTR;
          *(u32x4*)(Ks + nb + ksoff) = kreg; *(u32x2*)(Vs + nb + vsoff) = (u32x2){vreg.x, vreg.y}; *(u32x2*)(Vs + nb + vsoff + 16) = (u32x2){vreg.z, vreg.w}; }
        __syncthreads();
    }
    int tid2 = threadIdx.x; asm volatile("" : "+v"(tid2));
    const int lane2 = tid2 & 63, w2 = tid2 >> 6;
#pragma unroll
    for (int blk = 0; blk < 2; ++blk) {
        const float lsum = st.lrun[blk];
        const float inv = 1.0f / (lsum + __shfl_xor(lsum, 32));
        bf16_t* op = O + ((size_t)b * SEQ + qt * 128 + 64 * (w2 & 1) + 32 * blk + (lane2 & 31)) * D + (type ? 512 : 0) + 64 * (kvh * 4 + (w2 >> 1)) + ((lane2 >> 5) ? 0 : 16);
#pragma unroll
        for (int half = 0; half < 2; ++half) {
            unsigned px[4], py[4];
#pragma unroll
            for (int gq = 0; gq < 4; ++gq) { px[gq] = pk2(st.o[blk][half][4 * gq] * inv, st.o[blk][half][4 * gq + 1] * inv); py[gq] = pk2(st.o[blk][half][4 * gq + 2] * inv, st.o[blk][half][4 * gq + 3] * inv); }
#pragma unroll
            for (int j = 0; j < 2; ++j) {
                const auto sx = __builtin_amdgcn_permlane32_swap(px[2 + j], px[j], false, false);
                const auto sy = __builtin_amdgcn_permlane32_swap(py[2 + j], py[j], false, false);
                *(u32x4*)(op + 32 * half + 8 * j) = (u32x4){sx[0], sy[0], sx[1], sy[1]};
            }
        }
    }
}
__device__ __forceinline__ void phase_attn(const Params& p, int li, unsigned char* lds) {
    const bf16_t* PROJ = (const bf16_t*)(p.ws + WS_BIG + BIG_PROJ); const bf16_t* VT = (const bf16_t*)(p.ws + WS_BIG + BIG_VT); bf16_t* O = (bf16_t*)(p.ws + WS_BIG + BIG_O);
    const float* sink = p.in[3] + li * 8;
    if (gridDim.x == 256) {
        const int bk = blockIdx.x & 7, idx = blockIdx.x >> 3;
        for (int i = 0; i < 2; ++i) attn_unit<1>(lds, PROJ, VT, O, sink, bk >> 1, bk & 1, 32 * i + idx);
        for (int i = 0; i < 2; ++i) attn_unit<0>(lds, PROJ, VT, O, sink, bk >> 1, bk & 1, 32 * i + idx);
    } else {
        for (int u = blockIdx.x; u < 1024; u += gridDim.x) {
            const int v = u & 511; const int qt = v & 63, bk = v >> 6;
            if (u < 512) attn_unit<1>(lds, PROJ, VT, O, sink, bk >> 1, bk & 1, qt); else attn_unit<0>(lds, PROJ, VT, O, sink, bk >> 1, bk & 1, qt);
        }
    }
}

constexpr int VSTR = 272;
__device__ __forceinline__ void phase_sgu_mix(const Params& p, int li, unsigned char* lds) {
    int tid_ = threadIdx.x; asm volatile("" : "+v"(tid_)); const int tid = tid_, lane = tid & 63, w = tid >> 6, r32 = lane & 31, hi = lane >> 5;
    const bf16_t* Z = (const bf16_t*)(p.ws + WS_BIG + BIG_Z); bf16_t* Y = (bf16_t*)(p.ws + WS_BIG + BIG_Y);
    const bf16_t* WSB = (const bf16_t*)(p.ws + WS_WS) + (size_t)li * 8 * 128 * 128;
    const float* lng = p.in[9] + li * D; const float* lnb = p.in[10] + li * D; const float* bs = p.in[12] + li * 8 * 128;
    f32x2_t* stats = (f32x2_t*)(lds + 128 * VSTR);
    unsigned char* VTl = lds;
    for (int c = blockIdx.x; c < M / 128; c += gridDim.x) {
        const size_t row0 = (size_t)c * 128;
#pragma unroll 8
        for (int i = 0; i < 16; ++i) {
            const int row = w * 16 + i;
            const u32x4* src = (const u32x4*)(Z + (row0 + row) * SGU_IN + 1024 + 16 * lane);
            const u32x4 a = src[0], bq = src[1];
            float x[16]; x[0] = bf_lo(a.x); x[1] = bf_hi(a.x); x[2] = bf_lo(a.y); x[3] = bf_hi(a.y); x[4] = bf_lo(a.z); x[5] = bf_hi(a.z); x[6] = bf_lo(a.w); x[7] = bf_hi(a.w);
            x[8] = bf_lo(bq.x); x[9] = bf_hi(bq.x); x[10] = bf_lo(bq.y); x[11] = bf_hi(bq.y); x[12] = bf_lo(bq.z); x[13] = bf_hi(bq.z); x[14] = bf_lo(bq.w); x[15] = bf_hi(bq.w);
            float s = 0.f;
#pragma unroll
            for (int e = 0; e < 16; ++e) s += x[e];
            const float mean = wave_sum(s) * (1.0f / 1024.0f);
            float q = 0.f;
#pragma unroll
            for (int e = 0; e < 16; ++e) { const float d = x[e] - mean; q += d * d; }
            const float rstd = rsqrtf(wave_sum(q) * (1.0f / 1024.0f) + EPS);
            if (lane == 0) stats[row] = (f32x2_t){mean, rstd};
        }
        __syncthreads();
        const int q = tid & 127; const f32x2_t stq = stats[q];
        const int pt = w & 3, dh = w >> 2;
        u32x4 vraw[4];
#pragma unroll
        for (int i = 0; i < 4; ++i) vraw[i] = *(const u32x4*)(Z + (row0 + q) * SGU_IN + 1024 + 8 * ((tid >> 7) + 4 * i));
#pragma unroll 1
        for (int g = 0; g < 8; ++g) {
#pragma unroll
            for (int i = 0; i < 4; ++i) { const int dch = (tid >> 7) + 4 * i; const int dcol = g * 128 + 8 * dch; const u32x4 raw = vraw[i];
                float x[8]; x[0] = bf_lo(raw.x); x[1] = bf_hi(raw.x); x[2] = bf_lo(raw.y); x[3] = bf_hi(raw.y); x[4] = bf_lo(raw.z); x[5] = bf_hi(raw.z); x[6] = bf_lo(raw.w); x[7] = bf_hi(raw.w);
                const f32x4 ga = *(const f32x4*)(lng + dcol), gb = *(const f32x4*)(lng + dcol + 4), ba = *(const f32x4*)(lnb + dcol), bb = *(const f32x4*)(lnb + dcol + 4);
                const float gg[8] = {ga[0], ga[1], ga[2], ga[3], gb[0], gb[1], gb[2], gb[3]}, bbv[8] = {ba[0], ba[1], ba[2], ba[3], bb[0], bb[1], bb[2], bb[3]};
#pragma unroll
                for (int e = 0; e < 8; ++e) { const float y = (x[e] - stq.x) * stq.y * gg[e] + bbv[e];
                    *(bf16_t*)(VTl + (8 * dch + e) * VSTR + q * 2) = (bf16_t)(pk2(y, 0.f) & 0xffff); } }
            if (g < 7) {
#pragma unroll
                for (int i = 0; i < 4; ++i) vraw[i] = *(const u32x4*)(Z + (row0 + q) * SGU_IN + 1024 + (g + 1) * 128 + 8 * ((tid >> 7) + 4 * i));
            }
            bf16x8 af[8];
            { const bf16_t* ap = WSB + (size_t)g * 128 * 128 + (32 * pt + r32) * 128 + 8 * hi;
#pragma unroll
              for (int k = 0; k < 8; ++k) af[k] = *(const bf16x8*)(ap + 16 * k); }
            float bsv[16]; bf16_t uu[2][16];
#pragma unroll
            for (int r = 0; r < 16; ++r) { const int pr = 32 * pt + (r & 3) + 8 * (r >> 2) + 4 * hi; bsv[r] = bs[g * 128 + pr];
                uu[0][r] = Z[(row0 + pr) * SGU_IN + g * 128 + 64 * dh + r32]; uu[1][r] = Z[(row0 + pr) * SGU_IN + g * 128 + 64 * dh + 32 + r32]; }
            __syncthreads();
#pragma unroll
            for (int nt = 0; nt < 2; ++nt) {
                f32x16 acc;
#pragma unroll
                for (int r = 0; r < 16; ++r) acc[r] = 0.f;
                const unsigned char* bp = VTl + (64 * dh + 32 * nt + r32) * VSTR + hi * 16;
#pragma unroll
                for (int k = 0; k < 8; ++k) { const bf16x8 bfr = *(const bf16x8*)(bp + k * 32); acc = MFMA32(af[k], bfr, acc); }
                const int dcol = g * 128 + 64 * dh + 32 * nt + r32;
#pragma unroll
                for (int r = 0; r < 16; ++r) { const int pr = 32 * pt + (r & 3) + 8 * (r >> 2) + 4 * hi;
                    const float mixed = acc[r] + bsv[r];
                    Y[(row0 + pr) * D + dcol] = (bf16_t)(pk2(bf1(uu[nt][r]) * mixed, 0.f) & 0xffff); }
            }
            __syncthreads();
        }
    }
}
#define LAS __attribute__((address_space(3)))
#define XB_TMO      128
#define XB_XCNT(j)  (256  + 64 * (j))
#define XB_XSUB(j)  (1280 + 64 * (j))
#define XB_XGEN(j)  (2304 + 64 * (j))
#define XB_TOP      3328
#define XB_TOPGEN   3392
#define XCD_BAR_WORDS 3456
#define XB_SPIN_CAP (1u << 18)

__device__ __forceinline__ unsigned xb_ld(unsigned* p)              { return __hip_atomic_load(p, __ATOMIC_RELAXED, __HIP_MEMORY_SCOPE_AGENT); }
__device__ __forceinline__ unsigned xb_add(unsigned* p, unsigned v) { return __hip_atomic_fetch_add(p, v, __ATOMIC_RELAXED, __HIP_MEMORY_SCOPE_AGENT); }
__device__ __forceinline__ unsigned xb_xcc_id() { return (unsigned)__builtin_amdgcn_s_getreg((3 << 11) | 20) & 0xFu; }
#define XB_SPIN(cond, bar) do { unsigned _sp = 0; while (cond) { __builtin_amdgcn_s_sleep(1); \
    if ((++_sp & 255u) == 0u) { if (xb_ld(&(bar)[XB_TMO])) break; if (_sp > XB_SPIN_CAP) { atomicAdd(&(bar)[XB_TMO], 1u); break; } } } } while (0)

struct XcdBarrier {
    unsigned* bar; unsigned x;
    volatile LAS unsigned* st;
};

__device__ __forceinline__ XcdBarrier xcd_barrier_post(unsigned* bar, volatile LAS unsigned* st) {
    XcdBarrier b; b.bar = bar; b.x = xb_xcc_id(); b.st = st;
    if (threadIdx.x == 0) (void)xb_add(&bar[XB_XCNT(b.x)], 1u);
    return b;
}
__device__ __forceinline__ void xcd_barrier_complete(unsigned* bar, unsigned x, unsigned& nloc, unsigned& nx) {
    const unsigned G = gridDim.x * gridDim.y * gridDim.z;
    unsigned sum, cnt, mine, sp = 0u;
    for (;;) {
        sum = 0u; cnt = 0u; mine = 0u;
#pragma unroll
        for (unsigned j = 0; j < 16; ++j) { const unsigned c = xb_ld(&bar[XB_XCNT(j)]); sum += c; cnt += (c > 0u) ? 1u : 0u; mine = (j == x) ? c : mine; }
        if (sum == G) break;
        __builtin_amdgcn_s_sleep(1);
        if ((++sp & 255u) == 0u) { if (xb_ld(&bar[XB_TMO])) break; if (sp > XB_SPIN_CAP) { atomicAdd(&bar[XB_TMO], 1u); break; } }
    }
    nloc = mine > 0u ? mine : 1u; nx = cnt > 0u ? cnt : 1u;
}

__device__ __forceinline__ void xcd_barrier(const XcdBarrier& b) {
    asm volatile("s_waitcnt vmcnt(0)" ::: "memory");
    __syncthreads();
    if (threadIdx.x == 0) {
        unsigned* bar = b.bar;
        __builtin_amdgcn_s_waitcnt(0);
        unsigned nloc = b.st[0], nx = b.st[1];
        if (nloc == 0u) { xcd_barrier_complete(bar, b.x, nloc, nx); b.st[0] = nloc; b.st[1] = nx; }
        const unsigned old = xb_add(&bar[XB_XSUB(b.x)], 1u);
        const unsigned gen = old / nloc;
        if (old + 1u == (gen + 1u) * nloc) {
            __builtin_amdgcn_fence(__ATOMIC_RELEASE, "agent");
            asm volatile("s_waitcnt vmcnt(0)" ::: "memory");
            const unsigned og = xb_add(&bar[XB_TOP], 1u);
            const unsigned tg = og / nx;
            if (og + 1u == (tg + 1u) * nx) xb_add(&bar[XB_TOPGEN], 1u);
            else XB_SPIN(xb_ld(&bar[XB_TOPGEN]) == tg, bar);
            __builtin_amdgcn_fence(__ATOMIC_ACQUIRE, "agent");
            xb_add(&bar[XB_XGEN(b.x)], 1u);
            asm volatile("s_waitcnt vmcnt(0)" ::: "memory");
        } else {
            XB_SPIN(xb_ld(&bar[XB_XGEN(b.x)]) == gen, bar);
            __builtin_amdgcn_fence(__ATOMIC_ACQUIRE, "agent");
            asm volatile("s_waitcnt vmcnt(0)" ::: "memory");
        }
    }
    __syncthreads();
}
__host__ __device__ __forceinline__ bool phase_exists(int ph) { if (ph == 0 || ph == NPHASE - 1) return true; const int L = (ph - 1) >> 3, s = (ph - 1) & 7; return !((L & 1) && s == 3) && s != 0 && s != 5 && !(!(L & 1) && s == 2); }

__device__ __forceinline__ void run_phase(const Params& p, int ph, unsigned char* lds) {
    PG8_LAS unsigned char* lds3 = (PG8_LAS unsigned char*)lds;
    bf16_t* XN = (bf16_t*)(p.ws + WS_XN);
#ifndef NO_PRO
    if (ph == 0) { phase_prologue(p, lds); phase_cast_x(p.in[0], XN, (float*)(p.ws + WS_SSQ2)); return; }
#endif
    if (ph == NPHASE - 1) { phase_final_norm(XN, p.out, p.in[17]); return; }
    const int L = (ph - 1) >> 3, s = (ph - 1) & 7, li = L >> 1; const bool att = !(L & 1);
    float* SSQ = (float*)(p.ws + WS_SSQ2);
#ifndef NO_G1
    if (s == 1 && att) {
        pg8::Gemm g{XN, (const bf16_t*)(p.ws + WS_WATT_IN) + (size_t)li * ATT_IN * D, M, ATT_IN, D};
        pg8::EpiAttIn E{(bf16_t*)(p.ws + WS_BIG + BIG_PROJ), (bf16_t*)(p.ws + WS_BIG + BIG_VT), SSQ, (const pg8::f32x2*)(p.ws + WS_ROPE1), (const pg8::f32x2*)(p.ws + WS_ROPER), (const pg8::f32x2*)(p.ws + WS_ROPEC), p.in[4] + li * 64, p.in[5] + li * 64};
        pg8::StaticOrder S; S.init(g.M, g.N, (int)gridDim.x, (int)blockIdx.x);
        pg8::gemm_phase<pg8::EpiAttIn, pg8::StaticOrder, true, true>(lds3, g, S, E);
        return;
    }
    if (s == 1 || s == 6) {
        pg8::Gemm g; pg8::EpiBf16 E;
        if (s == 6)   { g = pg8::Gemm{XN, (const bf16_t*)(p.ws + WS_W1) + (size_t)L * DFF * D, M, DFF, D}; E = pg8::EpiBf16{(bf16_t*)(p.ws + WS_BIG + BIG_HID), DFF, 1, SSQ}; }
        else          { g = pg8::Gemm{XN, (const bf16_t*)(p.ws + WS_WSGU_IN) + (size_t)li * SGU_IN * D, M, SGU_IN, D}; E = pg8::EpiBf16{(bf16_t*)(p.ws + WS_BIG + BIG_Z), SGU_IN, 2, SSQ}; }
        pg8::StaticOrder S; S.init(g.M, g.N, (int)gridDim.x, (int)blockIdx.x);
        pg8::gemm_phase<pg8::EpiBf16, pg8::StaticOrder, true, true>(lds3, g, S, E);
        return;
    }
#endif
#ifndef NO_G2
    if (s == 4 || s == 7) {
        pg8::Gemm g; pg8::EpiResid E;
        if (s == 7)   { g = pg8::Gemm{(const bf16_t*)(p.ws + WS_BIG + BIG_HID), (const bf16_t*)(p.ws + WS_W2) + (size_t)L * D * DFF, M, D, DFF}; E = pg8::EpiResid{XN, SSQ, D}; }
        else if (att) { g = pg8::Gemm{(const bf16_t*)(p.ws + WS_BIG + BIG_O), (const bf16_t*)(p.ws + WS_WATT_OUT) + (size_t)li * D * D, M, D, D}; E = pg8::EpiResid{XN, SSQ, D}; }
        else          { g = pg8::Gemm{(const bf16_t*)(p.ws + WS_BIG + BIG_Y), (const bf16_t*)(p.ws + WS_WSGU_OUT) + (size_t)li * D * D, M, D, D}; E = pg8::EpiResid{XN, SSQ, D}; }
        pg8::StaticOrder S; S.init(g.M, g.N, (int)gridDim.x, (int)blockIdx.x, s == 7 ? 1 : 0);
        pg8::gemm_phase<pg8::EpiResid, pg8::StaticOrder, true, true>(lds3, g, S, E);
        return;
    }
#endif
#ifndef NO_PREP
    if (s == 2 && att) { phase_prep(p, li); return; }
#endif
#ifndef NO_SGU
    if (s == 2 && !att) { phase_sgu_mix(p, li, lds); return; }
#endif
#ifndef NO_ATTN
    if (s == 3) { if (att) phase_attn(p, li, lds); return; }
#endif
}

__device__ __forceinline__ void xcd_barrier_work(const XcdBarrier& b, const Params& p, int kbar, unsigned char* lds) {
    asm volatile("s_waitcnt vmcnt(0)" ::: "memory");
    __syncthreads();
    if (threadIdx.x == 0) {
        unsigned* bar = b.bar;
        __builtin_amdgcn_s_waitcnt(0);
        unsigned nloc = b.st[0], nx = b.st[1];
        if (nloc == 0u) { xcd_barrier_complete(bar, b.x, nloc, nx); b.st[0] = nloc; b.st[1] = nx; }
        const unsigned old = xb_add(&bar[XB_XSUB(b.x)], 1u);
        const unsigned gen = old / nloc;
        if (old + 1u == (gen + 1u) * nloc) {
            __builtin_amdgcn_fence(__ATOMIC_RELEASE, "agent");
            asm volatile("s_waitcnt vmcnt(0)" ::: "memory");
            const unsigned og = xb_add(&bar[XB_TOP], 1u);
            const unsigned tg = og / nx;
            if (og + 1u == (tg + 1u) * nx) xb_add(&bar[XB_TOPGEN], 1u);
            else XB_SPIN(xb_ld(&bar[XB_TOPGEN]) == tg, bar);
            __builtin_amdgcn_fence(__ATOMIC_ACQUIRE, "agent");
            xb_add(&bar[XB_XGEN(b.x)], 1u);
            asm volatile("s_waitcnt vmcnt(0)" ::: "memory");
        } else {
            XB_SPIN(xb_ld(&bar[XB_XGEN(b.x)]) == gen, bar);
            __builtin_amdgcn_fence(__ATOMIC_ACQUIRE, "agent");
            asm volatile("s_waitcnt vmcnt(0)" ::: "memory");
        }
    }
    {
        const int wave = __builtin_amdgcn_readfirstlane(threadIdx.x >> 6);
        if (wave != 0 && gridDim.x == 256) deferred_convert_item(p, (kbar - 1) * 1792 + (int)blockIdx.x * 7 + (wave - 1), lds, wave, threadIdx.x & 63);
    }
    __syncthreads();
}
__global__ void __launch_bounds__(512, 2) mega_fwd(Params p) {
    extern __shared__ __attribute__((aligned(16))) unsigned char lds[];
    cg::grid_group grid = cg::this_grid();
    if (p.ph_lo < 0) grid.sync();
    volatile LAS unsigned* MISC = (volatile LAS unsigned*)((LAS unsigned char*)lds + 131072 + 320);
    if (threadIdx.x < 32) MISC[threadIdx.x] = 0u;
    __syncthreads();
    XcdBarrier bar = xcd_barrier_post((unsigned*)(p.ws + WS_CTL), MISC + 8);
    bool first = true; int kbar = 0;
    for (int ph = p.ph_lo; ph < p.ph_hi; ++ph) {
        if (!phase_exists(ph)) continue;
        if (!first) { unsigned stoff = 131072 + 320 + 32; asm volatile("" : "+s"(stoff)); bar.st = (volatile LAS unsigned*)((LAS unsigned char*)lds + stoff); ++kbar; xcd_barrier_work(bar, p, kbar, lds); }
        first = false;
        run_phase(p, ph, lds);
        __syncthreads();
    }
}

extern "C" void kernel_launch(void* const* d_in, const int* in_sizes, int n_in, void* d_out, int out_size, void* d_ws, size_t ws_size, hipStream_t stream) {
    static int grid = 0;
    if (grid == 0) {
        if (n_in != 18 || in_sizes[0] != M * D || out_size != M * D || ws_size < WS_END) { fprintf(stderr, "kernel_launch: unexpected shapes (n_in %d, in0 %d, out %d, ws %zu); nothing launched\n", n_in, n_in > 0 ? in_sizes[0] : -1, out_size, ws_size); grid = -1; return; }
        int dev = 0, cus = 0, per_cu = 0;
        if (hipGetDevice(&dev) != hipSuccess || hipDeviceGetAttribute(&cus, hipDeviceAttributeMultiprocessorCount, dev) != hipSuccess) { grid = -1; return; }
        if (hipFuncSetAttribute((const void*)mega_fwd, hipFuncAttributeMaxDynamicSharedMemorySize, LDS_BYTES) != hipSuccess) { fprintf(stderr, "kernel_launch: hipFuncSetAttribute failed\n"); grid = -1; return; }
        if (hipOccupancyMaxActiveBlocksPerMultiprocessor(&per_cu, (const void*)mega_fwd, 512, LDS_BYTES) != hipSuccess || per_cu < 1) { fprintf(stderr, "kernel_launch: occupancy query says %d\n", per_cu); per_cu = 1; }
        (void)hipGetLastError();
        grid = cus * per_cu;
    }
    if (grid < 0) return;
    if (hipMemsetAsync((char*)d_ws + WS_CTL, 0, 65536, stream) != hipSuccess) { fprintf(stderr, "kernel_launch: memset failed\n"); return; }
    Params p{};
    for (int i = 0; i < 18; ++i) p.in[i] = (const float*)d_in[i];
    p.out = (float*)d_out; p.ws = (unsigned char*)d_ws;
#if MK_ONE_LAUNCH
    p.ph_lo = 0; p.ph_hi = NPHASE;
    void* args[] = {&p};
    hipError_t e = hipLaunchCooperativeKernel((const void*)mega_fwd, dim3(grid), dim3(512), args, LDS_BYTES, stream);
    if (e != hipSuccess) fprintf(stderr, "cooperative launch failed: %s (grid %d)\n", hipGetErrorString(e), grid);
#else
    for (int ph = 0; ph < NPHASE; ++ph) {
        if (!phase_exists(ph)) continue;
        p.ph_lo = ph; p.ph_hi = ph + 1;
        hipLaunchKernelGGL(mega_fwd, dim3(grid), dim3(512), LDS_BYTES, stream, p);
    }
#endif
}
```

```cpp
#include <hip/hip_runtime.h>
#include <hip/hip_cooperative_groups.h>
#include <cstdio>
#include <cstdint>
namespace cg = cooperative_groups;
#ifndef MK_ONE_LAUNCH
#define MK_ONE_LAUNCH 1
#endif
namespace pg8 {
#define PG8_LAS __attribute__((address_space(3)))
typedef unsigned short bf16_t;
typedef short bf16x8 __attribute__((ext_vector_type(8)));
typedef float f32x4 __attribute__((ext_vector_type(4)));
typedef unsigned u32x4 __attribute__((ext_vector_type(4)));
constexpr int BM = 256, BK = 64, HALF = 128, HTB = HALF * BK * 2  , STAGE_BYTES = 8 * HTB, NXCD = 8, WGM = 8;

__host__ __device__ __forceinline__ int lds_byte(int r, int c) { const int st = (r >> 4) * 2 + (c >> 5), rr = r & 15, cc = c & 31, ob = rr * 64 + cc * 2; return st * 1024 + (ob ^ (((ob >> 9) & 1) << 5)); }
__host__ __device__ __forceinline__ void stage_rc(int b, int& R, int& C) { const int st = b / 1024, sb = b % 1024, swz = sb ^ (((sb >> 9) & 1) << 5); R = (st >> 1) * 16 + swz / 64; C = (st & 1) * 32 + (swz % 64) / 2; }
__host__ __device__ __forceinline__ int perm32(int rho) { const int n = rho >> 4, i = rho & 15; return 8 * (i >> 2) + 4 * n + (i & 3); }

struct Unit { int pm, pn; };
struct Gemm { const bf16_t* A; const bf16_t* Bt; int M, N, K; };

struct StaticOrder {
    int nM, nN, nwg, G, c, rev;
    __host__ __device__ void init(int M, int N, int G_, int c_, int rev_ = 0) { nM = M / BM; nN = N / BM; nwg = nM * nN; G = G_; c = c_; rev = rev_; }
    __host__ __device__ bool next(int i, Unit& u) const {
        const int nr = (nwg + G - 1) / G; if (i >= nr) return false;
        const long L = (long)(rev ? nr - 1 - i : i) * G + c; if (L >= nwg) return false;
        int wgid = (int)L; { const int q = nwg / NXCD, r = nwg % NXCD, xcd = wgid % NXCD, off = wgid / NXCD; wgid = (xcd < r ? xcd * (q + 1) : r * (q + 1) + (xcd - r) * q) + off; }
        const int nig = WGM * nN, gid = wgid / nig, fm = gid * WGM, gsz = (nM - fm) < WGM ? (nM - fm) : WGM;
        u.pm = fm + ((wgid % nig) % gsz); u.pn = (wgid % nig) / gsz; return true;
    }
    __device__ __forceinline__ void a_ready(const Unit&) const {}
    __device__ __forceinline__ void done(const Unit&) const {}
};
__device__ __forceinline__ unsigned cvt_pk_bf16(float lo, float hi) { unsigned r; asm volatile("v_cvt_pk_bf16_f32 %0, %1, %2" : "=v"(r) : "v"(lo), "v"(hi)); return r; }
typedef float f32x2 __attribute__((ext_vector_type(2)));
typedef unsigned u32x2 __attribute__((ext_vector_type(2)));
__device__ __forceinline__ float act_relu2(float v) { const float t = fmaxf(v, 0.f); return t * t; }
__device__ __forceinline__ float act_gelu_tanh(float v) {
    const float u = v * (0.7978845608028654f + 0.035677408136300125f * v * v);
    const float e = __builtin_amdgcn_exp2f(u * -2.885390081777927f);
    return v * __builtin_amdgcn_rcpf(1.0f + e);
}
struct EpiBf16 {
    static constexpr bool PERM = true, AFTER_DRAIN = false;
    bf16_t* O; int ldc; int act; const float* ssq;
    __device__ __forceinline__ void operator()(const f32x4 (&acc)[2][2][4][2], const Unit& u, int wr, int wc, int fr, int fq) const {
        const int row0 = u.pm * BM + wr * 64 + fr; const int col0 = u.pn * BM + wc * 32 + 8 * fq;
        f32x4 sv8[2][4]; float rs8[2][4];
#pragma unroll
        for (int ai = 0; ai < 2; ++ai)
#pragma unroll
            for (int m = 0; m < 4; ++m) sv8[ai][m] = *((const f32x4*)(ssq + (size_t)(row0 + ai * HALF + m * 16) * 16) + fq);
#pragma unroll
        for (int ai = 0; ai < 2; ++ai)
#pragma unroll
            for (int m = 0; m < 4; ++m) { float tot = (sv8[ai][m][0] + sv8[ai][m][1]) + (sv8[ai][m][2] + sv8[ai][m][3]); tot += __shfl_xor(tot, 16); tot += __shfl_xor(tot, 32);
                rs8[ai][m] = __builtin_amdgcn_rsqf(tot * (1.0f / 1024.0f) + 1e-6f); }
#pragma unroll
        for (int ai = 0; ai < 2; ++ai)
#pragma unroll
            for (int m = 0; m < 4; ++m) { const int row = row0 + ai * HALF + m * 16; bf16_t* rowp = O + (size_t)row * ldc + col0;
                const float rs = rs8[ai][m];
#pragma unroll
                for (int bj = 0; bj < 2; ++bj) { f32x4 v0 = acc[ai][bj][m][0] * rs, v1 = acc[ai][bj][m][1] * rs;
                    if (act == 1) {
#pragma unroll
                        for (int j = 0; j < 4; ++j) { v0[j] = act_relu2(v0[j]); v1[j] = act_relu2(v1[j]); }
                    } else if (act == 2) {
#pragma unroll
                        for (int j = 0; j < 4; ++j) { v0[j] = act_gelu_tanh(v0[j]); v1[j] = act_gelu_tanh(v1[j]); }
                    }
                    u32x4 w; w.x = cvt_pk_bf16(v0[0], v0[1]); w.y = cvt_pk_bf16(v0[2], v0[3]); w.z = cvt_pk_bf16(v1[0], v1[1]); w.w = cvt_pk_bf16(v1[2], v1[3]);
                    *(u32x4*)(rowp + bj * HALF) = w; } }
    }
    __device__ __forceinline__ void fused(f32x4 (&)[2][2][4][2], const Unit&, int, int, int, int, PG8_LAS unsigned char*, int, int) const {}
};
struct EpiResid {
    static constexpr bool PERM = true, AFTER_DRAIN = false;
    bf16_t* hb; float* ssq; int ldc;
    __device__ __forceinline__ void operator()(const f32x4 (&acc)[2][2][4][2], const Unit& u, int wr, int wc, int fr, int fq) const {
        const int row0 = u.pm * BM + wr * 64 + fr; const int col0 = u.pn * BM + wc * 32 + 8 * fq;
        float qv[2][4];
#pragma unroll
        for (int ai = 0; ai < 2; ++ai) {
            u32x4 bb[4][2];
#pragma unroll
            for (int m = 0; m < 4; ++m)
#pragma unroll
                for (int bj = 0; bj < 2; ++bj) bb[m][bj] = *(const u32x4*)(hb + (size_t)(row0 + ai * HALF + m * 16) * ldc + col0 + bj * HALF);
#pragma unroll
            for (int m = 0; m < 4; ++m) { const int row = row0 + ai * HALF + m * 16; bf16_t* rowp = hb + (size_t)row * ldc + col0; float q = 0.f;
#pragma unroll
                for (int bj = 0; bj < 2; ++bj) { const u32x4 b = bb[m][bj]; f32x4 v0 = acc[ai][bj][m][0], v1 = acc[ai][bj][m][1];
                    v0[0] += __uint_as_float(b.x << 16); v0[1] += __uint_as_float(b.x & 0xffff0000u); v0[2] += __uint_as_float(b.y << 16); v0[3] += __uint_as_float(b.y & 0xffff0000u);
                    v1[0] += __uint_as_float(b.z << 16); v1[1] += __uint_as_float(b.z & 0xffff0000u); v1[2] += __uint_as_float(b.w << 16); v1[3] += __uint_as_float(b.w & 0xffff0000u);
                    q += ((v0[0] * v0[0] + v0[1] * v0[1]) + (v0[2] * v0[2] + v0[3] * v0[3])) + ((v1[0] * v1[0] + v1[1] * v1[1]) + (v1[2] * v1[2] + v1[3] * v1[3]));
                    u32x4 w; w.x = cvt_pk_bf16(v0[0], v0[1]); w.y = cvt_pk_bf16(v0[2], v0[3]); w.z = cvt_pk_bf16(v1[0], v1[1]); w.w = cvt_pk_bf16(v1[2], v1[3]);
                    *(u32x4*)(rowp + bj * HALF) = w; }
                qv[ai][m] = q; }
        }
#pragma unroll
        for (int ai = 0; ai < 2; ++ai)
#pragma unroll
            for (int m = 0; m < 4; ++m) qv[ai][m] += __shfl_xor(qv[ai][m], 16);
#pragma unroll
        for (int ai = 0; ai < 2; ++ai)
#pragma unroll
            for (int m = 0; m < 4; ++m) { const float q = qv[ai][m] + __shfl_xor(qv[ai][m], 32);
                if (fq == 0) ssq[(size_t)(row0 + ai * HALF + m * 16) * 16 + u.pn * 4 + wc] = q; }
    }
    __device__ __forceinline__ void fused(f32x4 (&)[2][2][4][2], const Unit&, int, int, int, int, PG8_LAS unsigned char*, int, int) const {}
};
struct EpiAttIn {
    static constexpr bool PERM = true, AFTER_DRAIN = false;
    bf16_t* PROJ; bf16_t* VT; const float* ssq; const f32x2* r1; const f32x2* rr; const f32x2* rc; const float* qn; const float* kn;
    __device__ __forceinline__ void operator()(const f32x4 (&acc)[2][2][4][2], const Unit& u, int wr, int wc, int fr, int fq) const {
        const int pn = u.pn; const bool isB = pn >= 3; const int pt = isB ? pn - 3 : pn;
        const bool isQ = pt < 2, isV = (!isQ) && wc >= 2;
        const int row0 = u.pm * BM + wr * 64 + fr;
        const int dim0 = isB && !isV ? ((fq < 2) ? 8 * fq : 32 + 8 * (fq - 2)) : 8 * fq, dim1 = isB && !isV ? dim0 + 16 : 32 + 8 * fq;
        f32x4 g00 = {1.f, 1.f, 1.f, 1.f}, g01 = g00, g10 = g00, g11 = g00;
        if (isB && !isV) { const float* g = isQ ? qn : kn; g00 = *(const f32x4*)(g + dim0); g01 = *(const f32x4*)(g + dim0 + 4); g10 = *(const f32x4*)(g + dim1); g11 = *(const f32x4*)(g + dim1 + 4); }
        const int col = (isB ? 768 : 0) + (isQ ? 64 * (4 * pt + wc) : 512 + 64 * (wc & 1));
        f32x4 sv8[2][4]; float rs8[2][4];
#pragma unroll
        for (int ai = 0; ai < 2; ++ai)
#pragma unroll
            for (int m = 0; m < 4; ++m) sv8[ai][m] = *((const f32x4*)(ssq + (size_t)(row0 + ai * HALF + m * 16) * 16) + fq);
#pragma unroll
        for (int ai = 0; ai < 2; ++ai)
#pragma unroll
            for (int m = 0; m < 4; ++m) { float tot = (sv8[ai][m][0] + sv8[ai][m][1]) + (sv8[ai][m][2] + sv8[ai][m][3]); tot += __shfl_xor(tot, 16); tot += __shfl_xor(tot, 32);
                rs8[ai][m] = __builtin_amdgcn_rsqf(tot * (1.0f / 1024.0f) + 1e-6f); }
#pragma unroll
        for (int ai = 0; ai < 2; ++ai)
#pragma unroll
            for (int m = 0; m < 4; ++m) { const int row = row0 + ai * HALF + m * 16; const int pos = row & 8191;
                const float rs = rs8[ai][m];
                float x0[8], x1[8];
#pragma unroll
                for (int n = 0; n < 2; ++n)
#pragma unroll
                    for (int j = 0; j < 4; ++j) { x0[4 * n + j] = acc[ai][0][m][n][j] * rs; x1[4 * n + j] = acc[ai][1][m][n][j] * rs; }
                if (isV) {
                    const int b = row >> 13; bf16_t* vt = VT + ((size_t)(((b * 2 + (isB ? 1 : 0)) * 2 + (wc & 1)) * 64)) * 8192 + pos;
#pragma unroll
                    for (int e = 0; e < 8; e += 2) { const unsigned w0 = cvt_pk_bf16(x0[e], x0[e + 1]), w1 = cvt_pk_bf16(x1[e], x1[e + 1]);
                        vt[(size_t)(8 * fq + e) * 8192] = (bf16_t)(w0 & 0xffff); vt[(size_t)(8 * fq + e + 1) * 8192] = (bf16_t)(w0 >> 16);
                        vt[(size_t)(32 + 8 * fq + e) * 8192] = (bf16_t)(w1 & 0xffff); vt[(size_t)(32 + 8 * fq + e + 1) * 8192] = (bf16_t)(w1 >> 16); }
                } else {
                    const f32x2* tab;
                    if (isB) {
                        float ss = 0.f;
#pragma unroll
                        for (int e = 0; e < 8; ++e) ss += x0[e] * x0[e] + x1[e] * x1[e];
                        ss += __shfl_xor(ss, 16); ss += __shfl_xor(ss, 32);
                        const float hn = __builtin_amdgcn_rsqf(ss * (1.0f / 64.0f) + 1e-6f);
#pragma unroll
                        for (int e = 0; e < 4; ++e) { x0[e] *= hn * g00[e]; x0[4 + e] *= hn * g01[e]; x1[e] *= hn * g10[e]; x1[4 + e] *= hn * g11[e]; }
                        tab = (fq < 2) ? rr + (pos >> 6) * 16 + 8 * (fq & 1) : rc + (pos & 63) * 16 + 8 * (fq & 1);
                    } else tab = r1 + pos * 32 + 8 * fq;
                    const float qs = isQ ? 0.125f * 1.4426950408889634f : 1.0f;
                    float y0[8], y1[8];
#pragma unroll
                    for (int e = 0; e < 8; ++e) { const f32x2 cs = tab[e]; y0[e] = (x0[e] * cs.x - x1[e] * cs.y) * qs; y1[e] = (x1[e] * cs.x + x0[e] * cs.y) * qs; }
                    bf16_t* rowp = PROJ + (size_t)row * 1536 + col;
                    u32x4 w; w.x = cvt_pk_bf16(y0[0], y0[1]); w.y = cvt_pk_bf16(y0[2], y0[3]); w.z = cvt_pk_bf16(y0[4], y0[5]); w.w = cvt_pk_bf16(y0[6], y0[7]);
                    *(u32x4*)(rowp + dim0) = w;
                    w.x = cvt_pk_bf16(y1[0], y1[1]); w.y = cvt_pk_bf16(y1[2], y1[3]); w.z = cvt_pk_bf16(y1[4], y1[5]); w.w = cvt_pk_bf16(y1[6], y1[7]);
                    *(u32x4*)(rowp + dim1) = w;
                } }
    }
    __device__ __forceinline__ void fused(f32x4 (&)[2][2][4][2], const Unit&, int, int, int, int, PG8_LAS unsigned char*, int, int) const {}
};
template <class Epi, class Sched, bool ALIGN_EPI = false, bool SP2 = false>
__device__ __forceinline__ void gemm_phase(PG8_LAS unsigned char* lds, const Gemm g, const Sched& S, const Epi& E) {
    int tid_ = threadIdx.x; asm volatile("" : "+v"(tid_)); const int tid = tid_, wid = __builtin_amdgcn_readfirstlane(tid >> 6), lane = tid & 63, wr = wid >> 2, wc = wid & 3, fr = lane & 15, fq = lane >> 4;
    const int K = g.K, nt = K / BK;
    unsigned voffA[2], voffB[2];
#pragma unroll
    for (int i = 0; i < 2; ++i) { int R, C; stage_rc(tid * 16 + i * 8192, R, C); const int Rb = Epi::PERM ? ((R & ~31) + perm32(R & 31)) : R;
        voffA[i] = (unsigned)(R * K + C) * 2u; voffB[i] = (unsigned)(Rb * K + C) * 2u; }
    const size_t kstep = (size_t)(BK * 2);
    const size_t hstep = (size_t)HALF * K * 2;
    const size_t tstep = 2 * hstep;
    const unsigned ldsw = (unsigned)wid * 1024u;
    const int aoff = lds_byte(wr * 64 + fr, fq * 8), boff = lds_byte(wc * 32 + fr, fq * 8);
#define PG8_SA(b, h) (((b) * 2 + (h)) * HTB)
#define PG8_SB(b, h) ((4 + (b) * 2 + (h)) * HTB)
#define PG8_STAGE(bufoff, gbase, voff) do { _Pragma("unroll") for (int _i = 0; _i < 2; ++_i) \
        __builtin_amdgcn_global_load_lds((const unsigned*)((const char*)(gbase) + (voff)[_i]), (PG8_LAS unsigned*)(lds + (bufoff) + ldsw + _i * 8192), 16, 0, 0); } while (0)
#define PG8_LDA(dst, b, h) do { _Pragma("unroll") for (int m = 0; m < 4; ++m) _Pragma("unroll") for (int k = 0; k < 2; ++k) dst[m][k] = *(const PG8_LAS bf16x8*)(lds + PG8_SA(b, h) + aoff + m * 2048 + k * 1024); } while (0)
#define PG8_LDB(dst, b, h) do { _Pragma("unroll") for (int n = 0; n < 2; ++n) _Pragma("unroll") for (int k = 0; k < 2; ++k) dst[n][k] = *(const PG8_LAS bf16x8*)(lds + PG8_SB(b, h) + boff + n * 2048 + k * 1024); } while (0)
#define PG8_MMA(ai, bj, At, Bt) do { __builtin_amdgcn_s_setprio(1); _Pragma("unroll") for (int m = 0; m < 4; ++m) _Pragma("unroll") for (int n = 0; n < 2; ++n) _Pragma("unroll") for (int k = 0; k < 2; ++k) \
        acc[ai][bj][m][n] = __builtin_amdgcn_mfma_f32_16x16x32_bf16(Bt[n][k], At[m][k], acc[ai][bj][m][n], 0, 0, 0); __builtin_amdgcn_s_setprio(0); } while (0)
#define PG8_WAIT_V(n) asm volatile("s_waitcnt vmcnt(" #n ")" ::: "memory")
#define PG8_WAIT_L(n) asm volatile("s_waitcnt lgkmcnt(" #n ")" ::: "memory")
#define PG8_BAR __builtin_amdgcn_s_barrier()
#define PG8_SCHED __builtin_amdgcn_sched_barrier(0)
    Unit cur, nxt; int ui = 0;
    if (!S.next(0, cur)) return;
    f32x4 acc[2][2][4][2];
#pragma unroll
    for (int a = 0; a < 2; ++a)
#pragma unroll
        for (int b = 0; b < 2; ++b)
#pragma unroll
            for (int m = 0; m < 4; ++m)
#pragma unroll
                for (int n = 0; n < 2; ++n) acc[a][b][m][n] = (f32x4){0.f, 0.f, 0.f, 0.f};
    bf16x8 At[4][2], B0[2][2], B1[2][2];
    const char* cA = (const char*)g.A + (size_t)cur.pm * tstep; const char* cB = (const char*)g.Bt + (size_t)cur.pn * tstep;
    S.a_ready(cur);
    if constexpr (SP2) {
        PG8_STAGE(PG8_SB(0, 0), cB, voffB); PG8_STAGE(PG8_SB(0, 1), cB + hstep, voffB); PG8_STAGE(PG8_SA(0, 0), cA, voffA); PG8_STAGE(PG8_SA(0, 1), cA + hstep, voffA);
        if (wr == 1) PG8_BAR;
        PG8_WAIT_V(2); PG8_BAR;
        PG8_STAGE(PG8_SB(1, 0), cB + kstep, voffB); PG8_STAGE(PG8_SA(1, 0), cA + kstep, voffA); PG8_STAGE(PG8_SB(1, 1), cB + hstep + kstep, voffB);
        PG8_WAIT_V(6); PG8_BAR;
    } else {
        PG8_STAGE(PG8_SB(0, 0), cB, voffB); PG8_STAGE(PG8_SA(0, 0), cA, voffA); PG8_STAGE(PG8_SB(0, 1), cB + hstep, voffB); PG8_STAGE(PG8_SA(0, 1), cA + hstep, voffA);
        if (wr == 1) PG8_BAR;
        PG8_WAIT_V(4); PG8_BAR;
        PG8_STAGE(PG8_SB(1, 0), cB + kstep, voffB); PG8_STAGE(PG8_SA(1, 0), cA + kstep, voffA); PG8_STAGE(PG8_SB(1, 1), cB + hstep + kstep, voffB);
        PG8_WAIT_V(6); PG8_BAR;
    }
    for (;;) {
        const bool has_next = S.next(ui + 1, nxt);
        const char* nA = has_next ? (const char*)g.A + (size_t)nxt.pm * tstep : cA; const char* nB = has_next ? (const char*)g.Bt + (size_t)nxt.pn * tstep : cB;
        for (int t = 0; t < nt; t += 2) {
            const bool last = (t == nt - 2);
            const char* a1 = cA + (size_t)(t + 1) * kstep;
            const char* a2 = last ? nA : cA + (size_t)(t + 2) * kstep; const char* b2 = last ? nB : cB + (size_t)(t + 2) * kstep;
            const char* a3 = a2 + kstep; const char* b3 = b2 + kstep;
            if (last && has_next) S.a_ready(nxt);
            if constexpr (SP2) {
            PG8_LDB(B0, 0, 0); PG8_LDB(B1, 0, 1); PG8_SCHED; PG8_LDA(At, 0, 0); PG8_STAGE(PG8_SA(1, 1), a1 + hstep, voffA);
            PG8_WAIT_V(8); PG8_WAIT_L(0); PG8_BAR; PG8_MMA(0, 0, At, B0); PG8_MMA(0, 1, At, B1); PG8_BAR; PG8_SCHED;
            PG8_LDA(At, 0, 1); PG8_STAGE(PG8_SB(0, 0), b2, voffB); PG8_STAGE(PG8_SB(0, 1), b2 + hstep, voffB); PG8_STAGE(PG8_SA(0, 0), a2, voffA);
            PG8_WAIT_V(8); PG8_WAIT_L(0); PG8_BAR; PG8_MMA(1, 0, At, B0); PG8_MMA(1, 1, At, B1); PG8_BAR; PG8_SCHED;
            PG8_LDB(B0, 1, 0); PG8_LDB(B1, 1, 1); PG8_SCHED; PG8_LDA(At, 1, 0); PG8_STAGE(PG8_SA(0, 1), a2 + hstep, voffA);
            PG8_WAIT_V(8); PG8_WAIT_L(0); PG8_BAR; PG8_MMA(0, 0, At, B0); PG8_MMA(0, 1, At, B1); PG8_BAR; PG8_SCHED;
            PG8_LDA(At, 1, 1); PG8_STAGE(PG8_SB(1, 0), b3, voffB); PG8_STAGE(PG8_SB(1, 1), b3 + hstep, voffB); PG8_STAGE(PG8_SA(1, 0), a3, voffA);
            PG8_WAIT_V(8); PG8_WAIT_L(0); PG8_BAR; PG8_MMA(1, 0, At, B0); PG8_MMA(1, 1, At, B1); PG8_BAR; PG8_SCHED;
            } else {
            PG8_LDB(B0, 0, 0); PG8_SCHED; PG8_LDA(At, 0, 0); PG8_STAGE(PG8_SA(1, 1), a1 + hstep, voffA);
            PG8_WAIT_L(8); PG8_BAR; PG8_WAIT_L(0); PG8_MMA(0, 0, At, B0); PG8_BAR; PG8_SCHED;
            PG8_LDB(B1, 0, 1); PG8_STAGE(PG8_SB(0, 0), b2, voffB);
            PG8_BAR; PG8_WAIT_L(0); PG8_MMA(0, 1, At, B1); PG8_BAR;
            PG8_LDA(At, 0, 1); PG8_STAGE(PG8_SA(0, 0), a2, voffA);
            PG8_BAR; PG8_WAIT_L(0); PG8_MMA(1, 0, At, B0); PG8_BAR; PG8_SCHED;
            PG8_STAGE(PG8_SB(0, 1), b2 + hstep, voffB);
            PG8_WAIT_V(6); PG8_BAR; PG8_MMA(1, 1, At, B1); PG8_BAR;
            PG8_LDB(B0, 1, 0); PG8_SCHED; PG8_LDA(At, 1, 0); PG8_STAGE(PG8_SA(0, 1), a2 + hstep, voffA);
            PG8_WAIT_L(8); PG8_BAR; PG8_WAIT_L(0); PG8_MMA(0, 0, At, B0); PG8_BAR; PG8_SCHED;
            PG8_LDB(B1, 1, 1); PG8_STAGE(PG8_SB(1, 0), b3, voffB);
            PG8_BAR; PG8_WAIT_L(0); PG8_MMA(0, 1, At, B1); PG8_BAR;
            PG8_LDA(At, 1, 1); PG8_STAGE(PG8_SA(1, 0), a3, voffA);
            PG8_BAR; PG8_WAIT_L(0); PG8_MMA(1, 0, At, B0); PG8_BAR; PG8_SCHED;
            PG8_STAGE(PG8_SB(1, 1), b3 + hstep, voffB);
            PG8_WAIT_V(6); PG8_BAR; PG8_MMA(1, 1, At, B1); PG8_BAR;
            }
        }
        if constexpr (ALIGN_EPI) { if (wr == 0) PG8_BAR; }
        if constexpr (!Epi::AFTER_DRAIN) { E(acc, cur, wr, wc, fr, fq); S.done(cur); }
        if (!has_next) break;
#pragma unroll
        for (int a = 0; a < 2; ++a)
#pragma unroll
            for (int b = 0; b < 2; ++b)
#pragma unroll
                for (int m = 0; m < 4; ++m)
#pragma unroll
                    for (int n = 0; n < 2; ++n) acc[a][b][m][n] = (f32x4){0.f, 0.f, 0.f, 0.f};
        cur = nxt; cA = nA; cB = nB; ++ui;
        if constexpr (ALIGN_EPI) { if (wr == 1) PG8_BAR; }
    }
    PG8_WAIT_V(0);
    if constexpr (!ALIGN_EPI) { if (wr == 0) PG8_BAR; }
    PG8_BAR;
    if constexpr (Epi::AFTER_DRAIN) { E.fused(acc, cur, wr, wc, fr, fq, lds, wid, lane); S.done(cur); }
#undef PG8_SA
#undef PG8_SB
#undef PG8_STAGE
#undef PG8_LDA
#undef PG8_LDB
#undef PG8_MMA
#undef PG8_WAIT_V
#undef PG8_WAIT_L
#undef PG8_BAR
#undef PG8_SCHED
}
}
typedef unsigned short bf16_t;
typedef short bf16x8 __attribute__((ext_vector_type(8)));
typedef float f32x4 __attribute__((ext_vector_type(4)));
typedef float f32x16 __attribute__((ext_vector_type(16)));
typedef unsigned u32x4 __attribute__((ext_vector_type(4)));
typedef unsigned u32x2 __attribute__((ext_vector_type(2)));
typedef float f32x2_t __attribute__((ext_vector_type(2)));
typedef __bf16 bf16x2_t __attribute__((ext_vector_type(2)));

constexpr int D = 1024, BATCH = 4, SEQ = 8192, M = BATCH * SEQ, DFF = 4096, ATT_IN = 1536, SGU_IN = 2048, DEPTH = 4;
constexpr float EPS = 1e-6f, LOG2E = 1.4426950408889634f, QSCALE = 0.125f * 1.4426950408889634f;
constexpr size_t MiB = 1u << 20;
constexpr size_t WS_CTL = 0;
constexpr size_t WS_ROPE1 = 1 * MiB, WS_ROPER = 3 * MiB, WS_ROPEC = 3 * MiB + 16384, WS_WS = 3 * MiB + 512 * 1024;
constexpr size_t WS_WATT_IN = 4 * MiB, WS_WATT_OUT = 10 * MiB, WS_WSGU_IN = 14 * MiB, WS_WSGU_OUT = 22 * MiB, WS_W1 = 26 * MiB, WS_W2 = 58 * MiB;
constexpr size_t WS_XN = 90 * MiB, WS_BIG = 154 * MiB, WS_SSQ2 = 410 * MiB, WS_END = 412 * MiB;
constexpr size_t BIG_PROJ = 0, BIG_O = 96 * MiB, BIG_VT = 160 * MiB, BIG_Z = 0, BIG_Y = 128 * MiB, BIG_HID = 0;
constexpr int LDS_BYTES = 131072 + 2048;
constexpr int NPHASE = 34;

struct Params { const float* in[18]; float* out; unsigned char* ws; int ph_lo, ph_hi; };

__device__ __forceinline__ unsigned pk2(float lo, float hi) { f32x2_t v = {lo, hi}; bf16x2_t b = __builtin_convertvector(v, bf16x2_t); return __builtin_bit_cast(unsigned, b); }
__device__ __forceinline__ float bf_lo(unsigned w) { return __uint_as_float(w << 16); }
__device__ __forceinline__ float bf_hi(unsigned w) { return __uint_as_float(w & 0xffff0000u); }
__device__ __forceinline__ float bf1(bf16_t h) { return __uint_as_float(((unsigned)h) << 16); }
__device__ __forceinline__ float wave_sum(float v) {
#pragma unroll
    for (int o = 1; o < 64; o <<= 1) v += __shfl_xor(v, o);
    return v;
}
#define MFMA32(a, b, c) __builtin_amdgcn_mfma_f32_32x32x16_bf16((a), (b), (c), 0, 0, 0)

__device__ __forceinline__ int att_remap(int n) {
    const int pn = n >> 8, hq = (n >> 6) & 3, dl = n & 63; int bj, s;
    if (pn >= 3 && !(pn == 5 && hq >= 2)) { if (dl < 16) { bj = 0; s = dl; } else if (dl < 32) { bj = 1; s = dl - 16; } else if (dl < 48) { bj = 0; s = dl - 16; } else { bj = 1; s = dl - 32; } }
    else { bj = dl >> 5; s = dl & 31; }
    return 256 * pn + 128 * bj + 32 * hq + s;
}
__device__ __forceinline__ void transpose_load(float (&v)[32], const float* W, int N, int item, int lane) {
    const int nblk = N / 32, kb = item / nblk, nb = item % nblk, k0 = 64 * kb, n0 = 32 * nb;
    const float* src = W + (size_t)(k0 + (lane >> 5)) * N + n0 + (lane & 31);
#pragma unroll
    for (int i = 0; i < 32; ++i) v[i] = src[(size_t)(2 * i) * N];
}
__device__ __forceinline__ void transpose_store(const float (&v)[32], int K, int N, const float* gain, bf16_t* WT, float* scr, int item, int lane, bool remap) {
    const int nblk = N / 32, kb = item / nblk, nb = item % nblk, k0 = 64 * kb, n0 = 32 * nb;
    const int c = lane & 7;
    f32x4 g0 = {1.f, 1.f, 1.f, 1.f}, g1 = g0;
    if (gain) { g0 = *(const f32x4*)(gain + k0 + 8 * c); g1 = *(const f32x4*)(gain + k0 + 8 * c + 4); }
#pragma unroll
    for (int i = 0; i < 32; ++i) scr[(2 * i + (lane >> 5)) * 33 + (lane & 31)] = v[i];
    asm volatile("s_waitcnt lgkmcnt(0)" ::: "memory");
#pragma unroll
    for (int j = 0; j < 4; ++j) { const int n = (lane >> 3) + 8 * j; const float* s = scr + (8 * c) * 33 + n;
        u32x4 o; o.x = pk2(s[0 * 33] * g0[0], s[1 * 33] * g0[1]); o.y = pk2(s[2 * 33] * g0[2], s[3 * 33] * g0[3]); o.z = pk2(s[4 * 33] * g1[0], s[5 * 33] * g1[1]); o.w = pk2(s[6 * 33] * g1[2], s[7 * 33] * g1[3]);
        const int nrow = remap ? att_remap(n0 + n) : n0 + n;
        *(u32x4*)(WT + (size_t)nrow * K + k0 + 8 * c) = o; }
    asm volatile("s_waitcnt lgkmcnt(0)" ::: "memory");
}
__device__ __forceinline__ void phase_prologue(const Params& p, unsigned char* lds) {
    int tid_ = threadIdx.x; asm volatile("" : "+v"(tid_)); const int tid = tid_, lane = tid & 63, wave = tid >> 6;
    const int gw = blockIdx.x * 8 + wave, ngw = gridDim.x * 8;
    float* scr = (float*)(lds + wave * 16384);
    const int nmat = (gridDim.x == 256) ? 1 : 16;
    for (int mi = 0; mi < nmat; ++mi) {
        const float* W; const float* gain = nullptr; bf16_t* WT; int K = D, N;
        if (mi < 2)       { W = p.in[2] + (size_t)mi * D * ATT_IN; gain = p.in[1] + mi * D; N = ATT_IN; WT = (bf16_t*)(p.ws + WS_WATT_IN) + (size_t)mi * ATT_IN * D; }
        else if (mi < 4)  { const int i = mi - 2; W = p.in[6] + (size_t)i * D * D; N = D; WT = (bf16_t*)(p.ws + WS_WATT_OUT) + (size_t)i * D * D; }
        else if (mi < 6)  { const int i = mi - 4; W = p.in[8] + (size_t)i * D * SGU_IN; gain = p.in[7] + i * D; N = SGU_IN; WT = (bf16_t*)(p.ws + WS_WSGU_IN) + (size_t)i * SGU_IN * D; }
        else if (mi < 8)  { const int i = mi - 6; W = p.in[13] + (size_t)i * D * D; N = D; WT = (bf16_t*)(p.ws + WS_WSGU_OUT) + (size_t)i * D * D; }
        else if (mi < 12) { const int i = mi - 8; W = p.in[15] + (size_t)i * D * DFF; gain = p.in[14] + i * D; N = DFF; WT = (bf16_t*)(p.ws + WS_W1) + (size_t)i * DFF * D; }
        else              { const int i = mi - 12; W = p.in[16] + (size_t)i * DFF * D; K = DFF; N = D; WT = (bf16_t*)(p.ws + WS_W2) + (size_t)i * D * DFF; }
        const int items = (K / 64) * (N / 32);
        float va[32], vb[32];
        int it = gw;
        if (it < items) transpose_load(va, W, N, it, lane);
        for (; it < items; it += 2 * ngw) {
            const int it1 = it + ngw, it2 = it + 2 * ngw;
            if (it1 < items) transpose_load(vb, W, N, it1, lane);
            transpose_store(va, K, N, gain, WT, scr, it, lane, mi < 2);
            if (it2 < items) transpose_load(va, W, N, it2, lane);
            if (it1 < items) transpose_store(vb, K, N, gain, WT, scr, it1, lane, mi < 2);
        }
    }
    { const float* src = p.in[11]; bf16_t* dst = (bf16_t*)(p.ws + WS_WS); const int n4 = 2 * 8 * 128 * 128 / 4;
      for (int i = blockIdx.x * 512 + tid; i < n4; i += gridDim.x * 512) { const f32x4 v = *(const f32x4*)(src + 4 * (size_t)i); u32x2 o; o.x = pk2(v[0], v[1]); o.y = pk2(v[2], v[3]); *(u32x2*)(dst + 4 * (size_t)i) = o; } }
    { f32x2_t* r1 = (f32x2_t*)(p.ws + WS_ROPE1); f32x2_t* rr = (f32x2_t*)(p.ws + WS_ROPER); f32x2_t* rc = (f32x2_t*)(p.ws + WS_ROPEC);
      const int total = SEQ * 32 + 128 * 16 + 64 * 16;
      for (int i = blockIdx.x * 512 + tid; i < total; i += gridDim.x * 512) {
          int pos, fi; float fexp; f32x2_t* dst;
          if (i < SEQ * 32) { pos = i >> 5; fi = i & 31; fexp = (float)fi * (1.0f / 32.0f); dst = r1 + i; }
          else if (i < SEQ * 32 + 128 * 16) { const int j = i - SEQ * 32; pos = j >> 4; fi = j & 15; fexp = (float)fi * (1.0f / 16.0f); dst = rr + j; }
          else { const int j = i - SEQ * 32 - 128 * 16; pos = j >> 4; fi = j & 15; fexp = (float)fi * (1.0f / 16.0f); dst = rc + j; }
          const float freq = exp2f(-fexp * 13.287712379549449f);
          const float ang = (float)pos * freq;
          float tr = ang * 0.15915494309189535f; tr = tr - floorf(tr);
          const float sn = __builtin_amdgcn_sinf(tr), cs = __builtin_amdgcn_cosf(tr);
          *dst = (f32x2_t){cs, sn};
      } }
}

constexpr int DEFER_TOTAL = 512 + 2048 + 2048 + 1024 + 512 + 2048 + 2048 + 768 + 512 + 2048 + 2048 + 1024 + 512 + 2048 + 2048;
__device__ __forceinline__ void deferred_convert_item(const Params& p, int g, unsigned char* lds, int wave, int lane) {
    if (g >= DEFER_TOTAL) return;
    const float* W; const float* gain = nullptr; bf16_t* WT; int K = D, N = D; bool remap = false; int r = g;
    int kind, idx;
    if (r < 512) { kind = 0; idx = 0; } else if ((r -= 512) < 2048) { kind = 1; idx = 0; } else if ((r -= 2048) < 2048) { kind = 2; idx = 0; }
    else if ((r -= 2048) < 1024) { kind = 3; idx = 0; } else if ((r -= 1024) < 512) { kind = 4; idx = 0; } else if ((r -= 512) < 2048) { kind = 1; idx = 1; }
    else if ((r -= 2048) < 2048) { kind = 2; idx = 1; } else if ((r -= 2048) < 768) { kind = 5; idx = 1; } else if ((r -= 768) < 512) { kind = 0; idx = 1; }
    else if ((r -= 512) < 2048) { kind = 1; idx = 2; } else if ((r -= 2048) < 2048) { kind = 2; idx = 2; } else if ((r -= 2048) < 1024) { kind = 3; idx = 1; }
    else if ((r -= 1024) < 512) { kind = 4; idx = 1; } else if ((r -= 512) < 2048) { kind = 1; idx = 3; } else { r -= 2048; kind = 2; idx = 3; }
    if (kind == 0)      { W = p.in[6] + (size_t)idx * D * D; WT = (bf16_t*)(p.ws + WS_WATT_OUT) + (size_t)idx * D * D; }
    else if (kind == 1) { W = p.in[15] + (size_t)idx * D * DFF; gain = p.in[14] + idx * D; N = DFF; WT = (bf16_t*)(p.ws + WS_W1) + (size_t)idx * DFF * D; }
    else if (kind == 2) { W = p.in[16] + (size_t)idx * DFF * D; K = DFF; WT = (bf16_t*)(p.ws + WS_W2) + (size_t)idx * D * DFF; }
    else if (kind == 3) { W = p.in[8] + (size_t)idx * D * SGU_IN; gain = p.in[7] + idx * D; N = SGU_IN; WT = (bf16_t*)(p.ws + WS_WSGU_IN) + (size_t)idx * SGU_IN * D; }
    else if (kind == 4) { W = p.in[13] + (size_t)idx * D * D; WT = (bf16_t*)(p.ws + WS_WSGU_OUT) + (size_t)idx * D * D; }
    else                { W = p.in[2] + (size_t)idx * D * ATT_IN; gain = p.in[1] + idx * D; N = ATT_IN; WT = (bf16_t*)(p.ws + WS_WATT_IN) + (size_t)idx * ATT_IN * D; remap = true; }
    float v[32];
    transpose_load(v, W, N, r, lane);
    transpose_store(v, K, N, gain, WT, (float*)(lds + wave * 16384), r, lane, remap);
}
__device__ __forceinline__ void phase_cast_x(const float* src, bf16_t* dst, float* ssq) {
    int tid_ = threadIdx.x; asm volatile("" : "+v"(tid_)); const int tid = tid_, lane = tid & 63, wave = tid >> 6;
    const int gw = blockIdx.x * 8 + wave, ngw = gridDim.x * 8;
    for (int m0 = gw; m0 < M; m0 += 4 * ngw) {
        f32x4 v[4][4];
#pragma unroll
        for (int rr = 0; rr < 4; ++rr) { const int m = m0 + rr * ngw; if (m < M) { const f32x4* xr = (const f32x4*)(src + (size_t)m * D) + lane;
#pragma unroll
            for (int j = 0; j < 4; ++j) v[rr][j] = xr[64 * j]; } }
#pragma unroll
        for (int rr = 0; rr < 4; ++rr) { const int m = m0 + rr * ngw; if (m < M) { float s = 0.f;
#pragma unroll
            for (int j = 0; j < 4; ++j) s += (v[rr][j][0] * v[rr][j][0] + v[rr][j][1] * v[rr][j][1]) + (v[rr][j][2] * v[rr][j][2] + v[rr][j][3] * v[rr][j][3]);
            s = wave_sum(s);
            u32x2* o8 = (u32x2*)(dst + (size_t)m * D) + lane;
#pragma unroll
            for (int j = 0; j < 4; ++j) { u32x2 o; o.x = pk2(v[rr][j][0], v[rr][j][1]); o.y = pk2(v[rr][j][2], v[rr][j][3]); o8[64 * j] = o; }
            if (lane < 16) ssq[(size_t)m * 16 + lane] = lane == 0 ? s : 0.f; } }
    }
}
__device__ __forceinline__ void phase_norm(const float* src, bf16_t* dst) {
    int tid_ = threadIdx.x; asm volatile("" : "+v"(tid_)); const int tid = tid_, lane = tid & 63, wave = tid >> 6;
    const int gw = blockIdx.x * 8 + wave, ngw = gridDim.x * 8;
    for (int m = gw; m < M; m += ngw) {
        const f32x4* xr = (const f32x4*)(src + (size_t)m * D) + lane;
        f32x4 v[4]; float s = 0.f;
#pragma unroll
        for (int j = 0; j < 4; ++j) { v[j] = xr[64 * j]; s += (v[j][0] * v[j][0] + v[j][1] * v[j][1]) + (v[j][2] * v[j][2] + v[j][3] * v[j][3]); }
        const float rs = rsqrtf(wave_sum(s) * (1.0f / D) + EPS);
        u32x2* o8 = (u32x2*)(dst + (size_t)m * D) + lane;
#pragma unroll
        for (int j = 0; j < 4; ++j) { u32x2 o; o.x = pk2(v[j][0] * rs, v[j][1] * rs); o.y = pk2(v[j][2] * rs, v[j][3] * rs); o8[64 * j] = o; }
    }
}
__device__ __forceinline__ void phase_final_norm(const bf16_t* hb, float* out, const float* g) {
    int tid_ = threadIdx.x; asm volatile("" : "+v"(tid_)); const int tid = tid_, lane = tid & 63, wave = tid >> 6;
    const int gw = blockIdx.x * 8 + wave, ngw = gridDim.x * 8;
    f32x4 gg[4];
#pragma unroll
    for (int j = 0; j < 4; ++j) gg[j] = *((const f32x4*)g + lane + 64 * j);
    for (int m0 = gw; m0 < M; m0 += 4 * ngw) {
        u32x2 raw[4][4];
#pragma unroll
        for (int rr = 0; rr < 4; ++rr) { const int m = m0 + rr * ngw; if (m < M) { const u32x2* xr = (const u32x2*)(hb + (size_t)m * D) + lane;
#pragma unroll
            for (int j = 0; j < 4; ++j) raw[rr][j] = xr[64 * j]; } }
#pragma unroll
        for (int rr = 0; rr < 4; ++rr) { const int m = m0 + rr * ngw; if (m < M) { f32x4 v[4]; float s = 0.f;
#pragma unroll
            for (int j = 0; j < 4; ++j) { const u32x2 r = raw[rr][j]; v[j] = (f32x4){bf_lo(r.x), bf_hi(r.x), bf_lo(r.y), bf_hi(r.y)}; s += (v[j][0] * v[j][0] + v[j][1] * v[j][1]) + (v[j][2] * v[j][2] + v[j][3] * v[j][3]); }
            const float rs = rsqrtf(wave_sum(s) * (1.0f / D) + EPS);
            f32x4* o = (f32x4*)(out + (size_t)m * D) + lane;
#pragma unroll
            for (int j = 0; j < 4; ++j) o[64 * j] = v[j] * rs * gg[j]; } }
    }
}

__device__ __forceinline__ void phase_prep(const Params& p, int li) {
    int tid_ = threadIdx.x; asm volatile("" : "+v"(tid_)); const int tid = tid_, lane = tid & 63, wave = tid >> 6;
    bf16_t* PROJ = (bf16_t*)(p.ws + WS_BIG + BIG_PROJ); bf16_t* VT = (bf16_t*)(p.ws + WS_BIG + BIG_VT);
    const f32x2_t* r1 = (const f32x2_t*)(p.ws + WS_ROPE1); const f32x2_t* rr = (const f32x2_t*)(p.ws + WS_ROPER); const f32x2_t* rc = (const f32x2_t*)(p.ws + WS_ROPEC);
    const float* qn = p.in[4] + li * 64; const float* kn = p.in[5] + li * 64;
    for (int tt = blockIdx.x; tt < M / 64; tt += gridDim.x) {
        const int b = tt >> 7, s0 = (tt & 127) * 64;
        const int tok = tid >> 3, j = tid & 7; const int pos = s0 + tok; const size_t row = (size_t)tt * 64 + tok;
#pragma unroll 5
        for (int hs = 0; hs < 20; ++hs) {
            const bool isB = hs >= 10; const int h2 = isB ? hs - 10 : hs; const bool isQ = h2 < 8;
            const int col = (isB ? 768 : 0) + (isQ ? 64 * h2 : 512 + 64 * (h2 - 8));
            bf16_t* ptr = PROJ + row * ATT_IN + col + 8 * j;
            const u32x4 raw = *(const u32x4*)ptr;
            float x[8]; x[0] = bf_lo(raw.x); x[1] = bf_hi(raw.x); x[2] = bf_lo(raw.y); x[3] = bf_hi(raw.y); x[4] = bf_lo(raw.z); x[5] = bf_hi(raw.z); x[6] = bf_lo(raw.w); x[7] = bf_hi(raw.w);
            float y[8];
            if (!isB) {
#pragma unroll
                for (int e = 0; e < 8; ++e) { const float pr = __shfl_xor(x[e], 4); const f32x2_t cs = r1[pos * 32 + 8 * (j & 3) + e]; y[e] = x[e] * cs.x + ((j < 4) ? -pr : pr) * cs.y; }
            } else {
                float ss = 0.f;
#pragma unroll
                for (int e = 0; e < 8; ++e) ss += x[e] * x[e];
                ss += __shfl_xor(ss, 1); ss += __shfl_xor(ss, 2); ss += __shfl_xor(ss, 4);
                const float rs = rsqrtf(ss * (1.0f / 64.0f) + EPS); const float* gn = isQ ? qn : kn;
#pragma unroll
                for (int e = 0; e < 8; ++e) x[e] = x[e] * rs * gn[8 * j + e];
                const f32x2_t* tab = (j < 4) ? (rr + (pos >> 6) * 16) : (rc + (pos & 63) * 16);
#pragma unroll
                for (int e = 0; e < 8; ++e) { const float pr = __shfl_xor(x[e], 2); const f32x2_t cs = tab[8 * (j & 1) + e]; y[e] = x[e] * cs.x + ((j & 2) ? pr : -pr) * cs.y; }
            }
            if (isQ) {
#pragma unroll
                for (int e = 0; e < 8; ++e) y[e] *= QSCALE;
            }
            u32x4 o; o.x = pk2(y[0], y[1]); o.y = pk2(y[2], y[3]); o.z = pk2(y[4], y[5]); o.w = pk2(y[6], y[7]);
            *(u32x4*)ptr = o;
        }
#pragma unroll
        for (int i = 0; i < 4; ++i) {
            const int vcol = (wave * 4 + i) * 8; const int type = vcol >> 7, kvh = (vcol >> 6) & 1, d0 = vcol & 63;
            const int col = (type ? 1408 : 640) + kvh * 64 + d0;
            const u32x4 raw = *(const u32x4*)(PROJ + ((size_t)tt * 64 + lane) * ATT_IN + col);
            bf16_t* vt = VT + ((size_t)(((b * 2 + type) * 2 + kvh) * 64 + d0)) * SEQ + s0 + lane;
            vt[0 * SEQ] = (bf16_t)(raw.x & 0xffff); vt[1 * SEQ] = (bf16_t)(raw.x >> 16); vt[2 * SEQ] = (bf16_t)(raw.y & 0xffff); vt[3 * SEQ] = (bf16_t)(raw.y >> 16);
            vt[4 * SEQ] = (bf16_t)(raw.z & 0xffff); vt[5 * SEQ] = (bf16_t)(raw.z >> 16); vt[6 * SEQ] = (bf16_t)(raw.w & 0xffff); vt[7 * SEQ] = (bf16_t)(raw.w >> 16);
        }
    }
}

constexpr int KSTR = 144;
__device__ __forceinline__ float max3f(float a, float b, float c) { float r; asm("v_max3_f32 %0, %1, %2, %3" : "=v"(r) : "v"(a), "v"(b), "v"(c)); return r; }
__device__ __forceinline__ float max2f(float a, float b) { float r; asm("v_max_f32_e32 %0, %1, %2" : "=v"(r) : "v"(a), "v"(b)); return r; }
constexpr float ATT_THR = 10.0f;
__device__ __forceinline__ void qk_tile(f32x16& p0, f32x16& p1, const unsigned char* kb, const bf16x8 (&qr)[4], float cinit) {
#pragma unroll
    for (int r = 0; r < 16; ++r) { p0[r] = cinit; p1[r] = cinit; }
#pragma unroll
    for (int d0 = 0; d0 < 4; ++d0) {
        const bf16x8 a0 = *(const bf16x8*)(kb + d0 * 32), a1 = *(const bf16x8*)(kb + 32 * KSTR + d0 * 32);
        p0 = MFMA32(a0, qr[d0], p0); p1 = MFMA32(a1, qr[d0], p1);
    }
}
__device__ __forceinline__ void band_mask(f32x16& p0, f32x16& p1, int kb0) {
#pragma unroll
    for (int r = 0; r < 16; ++r) { const int dk = kb0 + (r & 3) + 8 * (r >> 2);
        if (dk > 128 || dk < -128) p0[r] = -INFINITY;
        if (dk + 32 > 128 || dk + 32 < -128) p1[r] = -INFINITY; }
}
#define SGB(mask, n) __builtin_amdgcn_sched_group_barrier(mask, n, 0)
__device__ __forceinline__ float sum16(const f32x16& x) {
    float r;
    asm("s_nop 1\n\tv_add_f32_e32 %0, %1, %2\n\tv_add_f32_e32 %0, %0, %3\n\tv_add_f32_e32 %0, %0, %4\n\tv_add_f32_e32 %0, %0, %5\n\tv_add_f32_e32 %0, %0, %6\n\tv_add_f32_e32 %0, %0, %7\n\tv_add_f32_e32 %0, %0, %8\n\t"
        "v_add_f32_e32 %0, %0, %9\n\tv_add_f32_e32 %0, %0, %10\n\tv_add_f32_e32 %0, %0, %11\n\tv_add_f32_e32 %0, %0, %12\n\tv_add_f32_e32 %0, %0, %13\n\tv_add_f32_e32 %0, %0, %14\n\tv_add_f32_e32 %0, %0, %15\n\tv_add_f32_e32 %0, %0, %16"
        : "=&v"(r) : "v"(x[0]), "v"(x[1]), "v"(x[2]), "v"(x[3]), "v"(x[4]), "v"(x[5]), "v"(x[6]), "v"(x[7]), "v"(x[8]), "v"(x[9]), "v"(x[10]), "v"(x[11]), "v"(x[12]), "v"(x[13]), "v"(x[14]), "v"(x[15]));
    return r;
}
template <int TYPE>
__device__ __forceinline__ void attn_soft(f32x16& sA, f32x16& sB, int kb0, float& tsum, u32x4 (&pw)[4]) {
    if (TYPE == 0) band_mask(sA, sB, kb0);
#pragma unroll
    for (int r = 0; r < 16; ++r) { sA[r] = __builtin_amdgcn_exp2f(sA[r]); sB[r] = __builtin_amdgcn_exp2f(sB[r]); }
    tsum = sum16(sA) + sum16(sB);
#pragma unroll
    for (int s = 0; s < 2; ++s) {
        pw[s]     = (u32x4){pk2(sA[8 * s], sA[8 * s + 1]), pk2(sA[8 * s + 2], sA[8 * s + 3]), pk2(sA[8 * s + 4], sA[8 * s + 5]), pk2(sA[8 * s + 6], sA[8 * s + 7])};
        pw[2 + s] = (u32x4){pk2(sB[8 * s], sB[8 * s + 1]), pk2(sB[8 * s + 2], sB[8 * s + 3]), pk2(sB[8 * s + 4], sB[8 * s + 5]), pk2(sB[8 * s + 6], sB[8 * s + 7])};
    }
}
struct AttnState2 { float mrun[2]; float lrun[2]; f32x16 o[2][2]; };
template <int TYPE>
__device__ __forceinline__ void attn_step2(AttnState2& st, const bf16x8 (&qr)[2][4], const unsigned char* kb, const unsigned char* vb, int kb0) {
    bf16x8 kf[8];
#pragma unroll
    for (int d0 = 0; d0 < 4; ++d0) { kf[2 * d0] = *(const bf16x8*)(kb + d0 * 32); kf[2 * d0 + 1] = *(const bf16x8*)(kb + 32 * KSTR + d0 * 32); }
    __builtin_amdgcn_sched_barrier(0);
    f32x16 s00, s01, s10, s11;
    { f32x16 z, z1;
#pragma unroll
      for (int r = 0; r < 16; ++r) { z[r] = 0.f; z1[r] = 0.f; }
      s00 = MFMA32(kf[0], qr[0][0], z); s01 = MFMA32(kf[1], qr[0][0], z);
#pragma unroll
      for (int d0 = 1; d0 < 4; ++d0) { s00 = MFMA32(kf[2 * d0], qr[0][d0], s00); s01 = MFMA32(kf[2 * d0 + 1], qr[0][d0], s01); }
      s10 = MFMA32(kf[0], qr[1][0], z1); s11 = MFMA32(kf[1], qr[1][0], z1);
#pragma unroll
      for (int d0 = 1; d0 < 4; ++d0) { s10 = MFMA32(kf[2 * d0], qr[1][d0], s10); s11 = MFMA32(kf[2 * d0 + 1], qr[1][d0], s11); } }
    bf16x8 vf[8];
#pragma unroll
    for (int c = 0; c < 4; ++c) { vf[2 * c] = *(const bf16x8*)(vb + c * 32); vf[2 * c + 1] = *(const bf16x8*)(vb + 32 * KSTR + c * 32); }
    if (__any(st.mrun[0] != 0.0f || st.mrun[1] != 0.0f)) {
#pragma unroll
        for (int r = 0; r < 16; ++r) { s00[r] -= st.mrun[0]; s01[r] -= st.mrun[0]; s10[r] -= st.mrun[1]; s11[r] -= st.mrun[1]; }
    }
    float pm0, pm1; u32x4 pw0[4], pw1[4];
    attn_soft<TYPE>(s00, s01, kb0, pm0, pw0);
#pragma unroll
    for (int c = 0; c < 4; ++c) { const bf16x8 pf = __builtin_bit_cast(bf16x8, pw0[c]); st.o[0][0] = MFMA32(vf[2 * c], pf, st.o[0][0]); st.o[0][1] = MFMA32(vf[2 * c + 1], pf, st.o[0][1]); }
    attn_soft<TYPE>(s10, s11, kb0 - 32, pm1, pw1);
#pragma unroll
    for (int c = 0; c < 4; ++c) { const bf16x8 pf = __builtin_bit_cast(bf16x8, pw1[c]); st.o[1][0] = MFMA32(vf[2 * c], pf, st.o[1][0]); st.o[1][1] = MFMA32(vf[2 * c + 1], pf, st.o[1][1]); }
#pragma unroll
    for (int k = 0; k < 8; ++k) SGB(0x008, 1);
#pragma unroll
    for (int k = 0; k < 8; ++k) { SGB(0x008, 1); SGB(0x002, 6); }
    SGB(0x100, 8);
#pragma unroll
    for (int k = 0; k < 8; ++k) { SGB(0x008, 1); SGB(0x002, 8); }
    __builtin_amdgcn_sched_barrier(0);
    st.lrun[0] += pm0; st.lrun[1] += pm1;
    if (__any(pm0 > 1024.0f || pm1 > 1024.0f)) {
        const float r0 = pm0 + __shfl_xor(pm0, 32), r1 = pm1 + __shfl_xor(pm1, 32);
        const float d0 = r0 > 1024.0f ? __builtin_amdgcn_logf(r0) : 0.0f, d1 = r1 > 1024.0f ? __builtin_amdgcn_logf(r1) : 0.0f;
        const float a0 = __builtin_amdgcn_exp2f(-d0), a1 = __builtin_amdgcn_exp2f(-d1);
#pragma unroll
        for (int r = 0; r < 16; ++r) { st.o[0][0][r] *= a0; st.o[0][1][r] *= a0; st.o[1][0][r] *= a1; st.o[1][1][r] *= a1; }
        st.lrun[0] *= a0; st.lrun[1] *= a1; st.mrun[0] += d0; st.mrun[1] += d1;
    }
}
template <int TYPE>
__device__ __forceinline__ void attn_unit(unsigned char* lds, const bf16_t* PROJ, const bf16_t* VT, bf16_t* O, const float* sink, int b, int kvh, int qt) {
    constexpr int type = TYPE;
    int tid_ = threadIdx.x; asm volatile("" : "+v"(tid_)); const int tid = tid_, lane = tid & 63, w = tid >> 6, r32 = lane & 31, hi = lane >> 5;
    const int hg = w >> 1, rh = w & 1, qhead = kvh * 4 + hg;
    const int qcol = (type ? 768 : 0) + 64 * qhead, kcol = (type ? 1280 : 512) + 64 * kvh;
    const size_t rowbase = (size_t)b * SEQ;
    const int qpos0 = qt * 128 + 64 * rh + r32;
    bf16x8 qr[2][4];
#pragma unroll
    for (int blk = 0; blk < 2; ++blk) { const bf16_t* qp = PROJ + (rowbase + qpos0 + 32 * blk) * ATT_IN + qcol + 8 * hi;
#pragma unroll
      for (int d0 = 0; d0 < 4; ++d0) qr[blk][d0] = *(const bf16x8*)(qp + 16 * d0); }
    int t_lo = 0, t_hi = SEQ / 64 - 1;
    if (type == 0) { t_lo = 2 * qt - 2 < 0 ? 0 : 2 * qt - 2; t_hi = 2 * qt + 3 > SEQ / 64 - 1 ? SEQ / 64 - 1 : 2 * qt + 3; }
    const int n = t_hi - t_lo + 1;
    const int srow = tid >> 3, sch = tid & 7;
    const bf16_t* kg = PROJ + (rowbase + (size_t)t_lo * 64 + srow) * ATT_IN + kcol + 8 * sch;
    const bf16_t* vg = VT + ((size_t)(((b * 2 + type) * 2 + kvh) * 64 + srow)) * SEQ + t_lo * 64 + 8 * sch;
    unsigned char* Ks = lds; unsigned char* Vs = lds + 2 * 64 * KSTR;
    const int ksoff = srow * KSTR + sch * 16;
    const int vsoff = srow * KSTR + (sch >> 1) * 32 + (sch & 1) * 8;
    const int foff = r32 * KSTR + hi * 16;
    { const u32x4 k0 = *(const u32x4*)kg, v0 = *(const u32x4*)vg;
      *(u32x4*)(Ks + ksoff) = k0; *(u32x2*)(Vs + vsoff) = (u32x2){v0.x, v0.y}; *(u32x2*)(Vs + vsoff + 16) = (u32x2){v0.z, v0.w}; }
    __syncthreads();
    AttnState2 st;
    const float l0 = (type == 0 && hi == 0) ? __builtin_amdgcn_exp2f(sink[qhead] * LOG2E) : 0.0f;
#pragma unroll
    for (int blk = 0; blk < 2; ++blk) { st.mrun[blk] = 0.0f; st.lrun[blk] = l0;
#pragma unroll
        for (int r = 0; r < 16; ++r) { st.o[blk][0][r] = 0.f; st.o[blk][1][r] = 0.f; } }
    for (int i = 0; i < n; ++i) {
        u32x4 kreg, vreg;
        { const int i1 = i + 1 < n ? i + 1 : i; kreg = *(const u32x4*)(kg + (size_t)i1 * 64 * ATT_IN); vreg = *(const u32x4*)(vg + i1 * 64); }
        const unsigned char* kb = Ks + (i & 1) * 64 * KSTR + foff; const unsigned char* vb = Vs + (i & 1) * 64 * KSTR + foff;
        const int kb0 = (t_lo + i) * 64 + 4 * hi - qpos0;
        attn_step2<TYPE>(st, qr, kb, vb, kb0);
        { const int nb = ((i + 1) & 1) * 64 * KSTR;
          *(u32x4*)(Ks + nb + ksoff) = kreg; *(u32x2*)(Vs + nb + vsoff) = (u32x2){vreg.x, vreg.y}; *(u32x2*)(Vs + nb + vsoff + 16) = (u32x2){vreg.z, vreg.w}; }
        __syncthreads();
    }
    int tid2 = threadIdx.x; asm volatile("" : "+v"(tid2));
    const int lane2 = tid2 & 63, w2 = tid2 >> 6;
#pragma unroll
    for (int blk = 0; blk < 2; ++blk) {
        const float lsum = st.lrun[blk];
        const float inv = 1.0f / (lsum + __shfl_xor(lsum, 32));
        bf16_t* op = O + ((size_t)b * SEQ + qt * 128 + 64 * (w2 & 1) + 32 * blk + (lane2 & 31)) * D + (type ? 512 : 0) + 64 * (kvh * 4 + (w2 >> 1)) + ((lane2 >> 5) ? 0 : 16);
#pragma unroll
        for (int half = 0; half < 2; ++half) {
            unsigned px[4], py[4];
#pragma unroll
            for (int gq = 0; gq < 4; ++gq) { px[gq] = pk2(st.o[blk][half][4 * gq] * inv, st.o[blk][half][4 * gq + 1] * inv); py[gq] = pk2(st.o[blk][half][4 * gq + 2] * inv, st.o[blk][half][4 * gq + 3] * inv); }
#pragma unroll
            for (int j = 0; j < 2; ++j) {
                const auto sx = __builtin_amdgcn_permlane32_swap(px[2 + j], px[j], false, false);
                const auto sy = __builtin_amdgcn_permlane32_swap(py[2 + j], py[j], false, false);
                *(u32x4*)(op + 32 * half + 8 * j) = (u32x4){sx[0], sy[0], sx[1], sy[1]};
            }
        }
    }
}
__device__ __forceinline__ void phase_attn(const Params& p, int li, unsigned char* lds) {
    const bf16_t* PROJ = (const bf16_t*)(p.ws + WS_BIG + BIG_PROJ); const bf16_t* VT = (const bf16_t*)(p.ws + WS_BIG + BIG_VT); bf16_t* O = (bf16_t*)(p.ws + WS_BIG + BIG_O);
    const float* sink = p.in[3] + li * 8;
    if (gridDim.x == 256) {
        const int bk = blockIdx.x & 7, idx = blockIdx.x >> 3;
        for (int i = 0; i < 2; ++i) attn_unit<1>(lds, PROJ, VT, O, sink, bk >> 1, bk & 1, 32 * i + idx);
        for (int i = 0; i < 2; ++i) attn_unit<0>(lds, PROJ, VT, O, sink, bk >> 1, bk & 1, 32 * i + idx);
    } else {
        for (int u = blockIdx.x; u < 1024; u += gridDim.x) {
            const int v = u & 511; const int qt = v & 63, bk = v >> 6;
            if (u < 512) attn_unit<1>(lds, PROJ, VT, O, sink, bk >> 1, bk & 1, qt); else attn_unit<0>(lds, PROJ, VT, O, sink, bk >> 1, bk & 1, qt);
        }
    }
}

constexpr int VSTR = 272;
__device__ __forceinline__ void phase_sgu_mix(const Params& p, int li, unsigned char* lds) {
    int tid_ = threadIdx.x; asm volatile("" : "+v"(tid_)); const int tid = tid_, lane = tid & 63, w = tid >> 6, r32 = lane & 31, hi = lane >> 5;
    const bf16_t* Z = (const bf16_t*)(p.ws + WS_BIG + BIG_Z); bf16_t* Y = (bf16_t*)(p.ws + WS_BIG + BIG_Y);
    const bf16_t* WSB = (const bf16_t*)(p.ws + WS_WS) + (size_t)li * 8 * 128 * 128;
    const float* lng = p.in[9] + li * D; const float* lnb = p.in[10] + li * D; const float* bs = p.in[12] + li * 8 * 128;
    f32x2_t* stats = (f32x2_t*)(lds + 128 * VSTR);
    unsigned char* VTl = lds;
    for (int c = blockIdx.x; c < M / 128; c += gridDim.x) {
        const size_t row0 = (size_t)c * 128;
#pragma unroll 8
        for (int i = 0; i < 16; ++i) {
            const int row = w * 16 + i;
            const u32x4* src = (const u32x4*)(Z + (row0 + row) * SGU_IN + 1024 + 16 * lane);
            const u32x4 a = src[0], bq = src[1];
            float x[16]; x[0] = bf_lo(a.x); x[1] = bf_hi(a.x); x[2] = bf_lo(a.y); x[3] = bf_hi(a.y); x[4] = bf_lo(a.z); x[5] = bf_hi(a.z); x[6] = bf_lo(a.w); x[7] = bf_hi(a.w);
            x[8] = bf_lo(bq.x); x[9] = bf_hi(bq.x); x[10] = bf_lo(bq.y); x[11] = bf_hi(bq.y); x[12] = bf_lo(bq.z); x[13] = bf_hi(bq.z); x[14] = bf_lo(bq.w); x[15] = bf_hi(bq.w);
            float s = 0.f;
#pragma unroll
            for (int e = 0; e < 16; ++e) s += x[e];
            const float mean = wave_sum(s) * (1.0f / 1024.0f);
            float q = 0.f;
#pragma unroll
            for (int e = 0; e < 16; ++e) { const float d = x[e] - mean; q += d * d; }
            const float rstd = rsqrtf(wave_sum(q) * (1.0f / 1024.0f) + EPS);
            if (lane == 0) stats[row] = (f32x2_t){mean, rstd};
        }
        __syncthreads();
        const int q = tid & 127; const f32x2_t stq = stats[q];
        const int pt = w & 3, dh = w >> 2;
        u32x4 vraw[4];
#pragma unroll
        for (int i = 0; i < 4; ++i) vraw[i] = *(const u32x4*)(Z + (row0 + q) * SGU_IN + 1024 + 8 * ((tid >> 7) + 4 * i));
#pragma unroll 1
        for (int g = 0; g < 8; ++g) {
#pragma unroll
            for (int i = 0; i < 4; ++i) { const int dch = (tid >> 7) + 4 * i; const int dcol = g * 128 + 8 * dch; const u32x4 raw = vraw[i];
                float x[8]; x[0] = bf_lo(raw.x); x[1] = bf_hi(raw.x); x[2] = bf_lo(raw.y); x[3] = bf_hi(raw.y); x[4] = bf_lo(raw.z); x[5] = bf_hi(raw.z); x[6] = bf_lo(raw.w); x[7] = bf_hi(raw.w);
                const f32x4 ga = *(const f32x4*)(lng + dcol), gb = *(const f32x4*)(lng + dcol + 4), ba = *(const f32x4*)(lnb + dcol), bb = *(const f32x4*)(lnb + dcol + 4);
                const float gg[8] = {ga[0], ga[1], ga[2], ga[3], gb[0], gb[1], gb[2], gb[3]}, bbv[8] = {ba[0], ba[1], ba[2], ba[3], bb[0], bb[1], bb[2], bb[3]};
#pragma unroll
                for (int e = 0; e < 8; ++e) { const float y = (x[e] - stq.x) * stq.y * gg[e] + bbv[e];
                    *(bf16_t*)(VTl + (8 * dch + e) * VSTR + q * 2) = (bf16_t)(pk2(y, 0.f) & 0xffff); } }
            if (g < 7) {
#pragma unroll
                for (int i = 0; i < 4; ++i) vraw[i] = *(const u32x4*)(Z + (row0 + q) * SGU_IN + 1024 + (g + 1) * 128 + 8 * ((tid >> 7) + 4 * i));
            }
            bf16x8 af[8];
            { const bf16_t* ap = WSB + (size_t)g * 128 * 128 + (32 * pt + r32) * 128 + 8 * hi;
#pragma unroll
              for (int k = 0; k < 8; ++k) af[k] = *(const bf16x8*)(ap + 16 * k); }
            float bsv[16]; bf16_t uu[2][16];
#pragma unroll
            for (int r = 0; r < 16; ++r) { const int pr = 32 * pt + (r & 3) + 8 * (r >> 2) + 4 * hi; bsv[r] = bs[g * 128 + pr];
                uu[0][r] = Z[(row0 + pr) * SGU_IN + g * 128 + 64 * dh + r32]; uu[1][r] = Z[(row0 + pr) * SGU_IN + g * 128 + 64 * dh + 32 + r32]; }
            __syncthreads();
#pragma unroll
            for (int nt = 0; nt < 2; ++nt) {
                f32x16 acc;
#pragma unroll
                for (int r = 0; r < 16; ++r) acc[r] = 0.f;
                const unsigned char* bp = VTl + (64 * dh + 32 * nt + r32) * VSTR + hi * 16;
#pragma unroll
                for (int k = 0; k < 8; ++k) { const bf16x8 bfr = *(const bf16x8*)(bp + k * 32); acc = MFMA32(af[k], bfr, acc); }
                const int dcol = g * 128 + 64 * dh + 32 * nt + r32;
#pragma unroll
                for (int r = 0; r < 16; ++r) { const int pr = 32 * pt + (r & 3) + 8 * (r >> 2) + 4 * hi;
                    const float mixed = acc[r] + bsv[r];
                    Y[(row0 + pr) * D + dcol] = (bf16_t)(pk2(bf1(uu[nt][r]) * mixed, 0.f) & 0xffff); }
            }
            __syncthreads();
        }
    }
}
#define LAS __attribute__((address_space(3)))
#define XB_TMO      128
#define XB_XCNT(j)  (256  + 64 * (j))
#define XB_XSUB(j)  (1280 + 64 * (j))
#define XB_XGEN(j)  (2304 + 64 * (j))
#define XB_TOP      3328
#define XB_TOPGEN   3392
#define XCD_BAR_WORDS 3456
#define XB_SPIN_CAP (1u << 18)

__device__ __forceinline__ unsigned xb_ld(unsigned* p)              { return __hip_atomic_load(p, __ATOMIC_RELAXED, __HIP_MEMORY_SCOPE_AGENT); }
__device__ __forceinline__ unsigned xb_add(unsigned* p, unsigned v) { return __hip_atomic_fetch_add(p, v, __ATOMIC_RELAXED, __HIP_MEMORY_SCOPE_AGENT); }
__device__ __forceinline__ unsigned xb_xcc_id() { return (unsigned)__builtin_amdgcn_s_getreg((3 << 11) | 20) & 0xFu; }
#define XB_SPIN(cond, bar) do { unsigned _sp = 0; while (cond) { __builtin_amdgcn_s_sleep(1); \
    if ((++_sp & 255u) == 0u) { if (xb_ld(&(bar)[XB_TMO])) break; if (_sp > XB_SPIN_CAP) { atomicAdd(&(bar)[XB_TMO], 1u); break; } } } } while (0)

struct XcdBarrier {
    unsigned* bar; unsigned x;
    volatile LAS unsigned* st;
};

__device__ __forceinline__ XcdBarrier xcd_barrier_post(unsigned* bar, volatile LAS unsigned* st) {
    XcdBarrier b; b.bar = bar; b.x = xb_xcc_id(); b.st = st;
    if (threadIdx.x == 0) (void)xb_add(&bar[XB_XCNT(b.x)], 1u);
    return b;
}
__device__ __forceinline__ void xcd_barrier_complete(unsigned* bar, unsigned x, unsigned& nloc, unsigned& nx) {
    const unsigned G = gridDim.x * gridDim.y * gridDim.z;
    unsigned sum, cnt, mine, sp = 0u;
    for (;;) {
        sum = 0u; cnt = 0u; mine = 0u;
#pragma unroll
        for (unsigned j = 0; j < 16; ++j) { const unsigned c = xb_ld(&bar[XB_XCNT(j)]); sum += c; cnt += (c > 0u) ? 1u : 0u; mine = (j == x) ? c : mine; }
        if (sum == G) break;
        __builtin_amdgcn_s_sleep(1);
        if ((++sp & 255u) == 0u) { if (xb_ld(&bar[XB_TMO])) break; if (sp > XB_SPIN_CAP) { atomicAdd(&bar[XB_TMO], 1u); break; } }
    }
    nloc = mine > 0u ? mine : 1u; nx = cnt > 0u ? cnt : 1u;
}

__device__ __forceinline__ void xcd_barrier(const XcdBarrier& b) {
    asm volatile("s_waitcnt vmcnt(0)" ::: "memory");
    __syncthreads();
    if (threadIdx.x == 0) {
        unsigned* bar = b.bar;
        __builtin_amdgcn_s_waitcnt(0);
        unsigned nloc = b.st[0], nx = b.st[1];
        if (nloc == 0u) { xcd_barrier_complete(bar, b.x, nloc, nx); b.st[0] = nloc; b.st[1] = nx; }
        const unsigned old = xb_add(&bar[XB_XSUB(b.x)], 1u);
        const unsigned gen = old / nloc;
        if (old + 1u == (gen + 1u) * nloc) {
            __builtin_amdgcn_fence(__ATOMIC_RELEASE, "agent");
            asm volatile("s_waitcnt vmcnt(0)" ::: "memory");
            const unsigned og = xb_add(&bar[XB_TOP], 1u);
            const unsigned tg = og / nx;
            if (og + 1u == (tg + 1u) * nx) xb_add(&bar[XB_TOPGEN], 1u);
            else XB_SPIN(xb_ld(&bar[XB_TOPGEN]) == tg, bar);
            __builtin_amdgcn_fence(__ATOMIC_ACQUIRE, "agent");
            xb_add(&bar[XB_XGEN(b.x)], 1u);
            asm volatile("s_waitcnt vmcnt(0)" ::: "memory");
        } else {
            XB_SPIN(xb_ld(&bar[XB_XGEN(b.x)]) == gen, bar);
            __builtin_amdgcn_fence(__ATOMIC_ACQUIRE, "agent");
            asm volatile("s_waitcnt vmcnt(0)" ::: "memory");
        }
    }
    __syncthreads();
}
__host__ __device__ __forceinline__ bool phase_exists(int ph) { if (ph == 0 || ph == NPHASE - 1) return true; const int L = (ph - 1) >> 3, s = (ph - 1) & 7; return !((L & 1) && s == 3) && s != 0 && s != 5 && !(!(L & 1) && s == 2); }

__device__ __forceinline__ void run_phase(const Params& p, int ph, unsigned char* lds) {
    PG8_LAS unsigned char* lds3 = (PG8_LAS unsigned char*)lds;
    bf16_t* XN = (bf16_t*)(p.ws + WS_XN);
#ifndef NO_PRO
    if (ph == 0) { phase_prologue(p, lds); phase_cast_x(p.in[0], XN, (float*)(p.ws + WS_SSQ2)); return; }
#endif
    if (ph == NPHASE - 1) { phase_final_norm(XN, p.out, p.in[17]); return; }
    const int L = (ph - 1) >> 3, s = (ph - 1) & 7, li = L >> 1; const bool att = !(L & 1);
    float* SSQ = (float*)(p.ws + WS_SSQ2);
#ifndef NO_G1
    if (s == 1 && att) {
        pg8::Gemm g{XN, (const bf16_t*)(p.ws + WS_WATT_IN) + (size_t)li * ATT_IN * D, M, ATT_IN, D};
        pg8::EpiAttIn E{(bf16_t*)(p.ws + WS_BIG + BIG_PROJ), (bf16_t*)(p.ws + WS_BIG + BIG_VT), SSQ, (const pg8::f32x2*)(p.ws + WS_ROPE1), (const pg8::f32x2*)(p.ws + WS_ROPER), (const pg8::f32x2*)(p.ws + WS_ROPEC), p.in[4] + li * 64, p.in[5] + li * 64};
        pg8::StaticOrder S; S.init(g.M, g.N, (int)gridDim.x, (int)blockIdx.x);
        pg8::gemm_phase<pg8::EpiAttIn, pg8::StaticOrder, true, true>(lds3, g, S, E);
        return;
    }
    if (s == 1 || s == 6) {
        pg8::Gemm g; pg8::EpiBf16 E;
        if (s == 6)   { g = pg8::Gemm{XN, (const bf16_t*)(p.ws + WS_W1) + (size_t)L * DFF * D, M, DFF, D}; E = pg8::EpiBf16{(bf16_t*)(p.ws + WS_BIG + BIG_HID), DFF, 1, SSQ}; }
        else          { g = pg8::Gemm{XN, (const bf16_t*)(p.ws + WS_WSGU_IN) + (size_t)li * SGU_IN * D, M, SGU_IN, D}; E = pg8::EpiBf16{(bf16_t*)(p.ws + WS_BIG + BIG_Z), SGU_IN, 2, SSQ}; }
        pg8::StaticOrder S; S.init(g.M, g.N, (int)gridDim.x, (int)blockIdx.x);
        pg8::gemm_phase<pg8::EpiBf16, pg8::StaticOrder, true, true>(lds3, g, S, E);
        return;
    }
#endif
#ifndef NO_G2
    if (s == 4 || s == 7) {
        pg8::Gemm g; pg8::EpiResid E;
        if (s == 7)   { g = pg8::Gemm{(const bf16_t*)(p.ws + WS_BIG + BIG_HID), (const bf16_t*)(p.ws + WS_W2) + (size_t)L * D * DFF, M, D, DFF}; E = pg8::EpiResid{XN, SSQ, D}; }
        else if (att) { g = pg8::Gemm{(const bf16_t*)(p.ws + WS_BIG + BIG_O), (const bf16_t*)(p.ws + WS_WATT_OUT) + (size_t)li * D * D, M, D, D}; E = pg8::EpiResid{XN, SSQ, D}; }
        else          { g = pg8::Gemm{(const bf16_t*)(p.ws + WS_BIG + BIG_Y), (const bf16_t*)(p.ws + WS_WSGU_OUT) + (size_t)li * D * D, M, D, D}; E = pg8::EpiResid{XN, SSQ, D}; }
        pg8::StaticOrder S; S.init(g.M, g.N, (int)gridDim.x, (int)blockIdx.x, s == 7 ? 1 : 0);
        pg8::gemm_phase<pg8::EpiResid, pg8::StaticOrder, true, true>(lds3, g, S, E);
        return;
    }
#endif
#ifndef NO_PREP
    if (s == 2 && att) { phase_prep(p, li); return; }
#endif
#ifndef NO_SGU
    if (s == 2 && !att) { phase_sgu_mix(p, li, lds); return; }
#endif
#ifndef NO_ATTN
    if (s == 3) { if (att) phase_attn(p, li, lds); return; }
#endif
}

__device__ __forceinline__ void xcd_barrier_work(const XcdBarrier& b, const Params& p, int kbar, unsigned char* lds) {
    asm volatile("s_waitcnt vmcnt(0)" ::: "memory");
    __syncthreads();
    if (threadIdx.x == 0) {
        unsigned* bar = b.bar;
        __builtin_amdgcn_s_waitcnt(0);
        unsigned nloc = b.st[0], nx = b.st[1];
        if (nloc == 0u) { xcd_barrier_complete(bar, b.x, nloc, nx); b.st[0] = nloc; b.st[1] = nx; }
        const unsigned old = xb_add(&bar[XB_XSUB(b.x)], 1u);
        const unsigned gen = old / nloc;
        if (old + 1u == (gen + 1u) * nloc) {
            __builtin_amdgcn_fence(__ATOMIC_RELEASE, "agent");
            asm volatile("s_waitcnt vmcnt(0)" ::: "memory");
            const unsigned og = xb_add(&bar[XB_TOP], 1u);
            const unsigned tg = og / nx;
            if (og + 1u == (tg + 1u) * nx) xb_add(&bar[XB_TOPGEN], 1u);
            else XB_SPIN(xb_ld(&bar[XB_TOPGEN]) == tg, bar);
            __builtin_amdgcn_fence(__ATOMIC_ACQUIRE, "agent");
            xb_add(&bar[XB_XGEN(b.x)], 1u);
            asm volatile("s_waitcnt vmcnt(0)" ::: "memory");
        } else {
            XB_SPIN(xb_ld(&bar[XB_XGEN(b.x)]) == gen, bar);
            __builtin_amdgcn_fence(__ATOMIC_ACQUIRE, "agent");
            asm volatile("s_waitcnt vmcnt(0)" ::: "memory");
        }
    }
    {
        const int wave = __builtin_amdgcn_readfirstlane(threadIdx.x >> 6);
        if (wave != 0 && gridDim.x == 256) deferred_convert_item(p, (kbar - 1) * 1792 + (int)blockIdx.x * 7 + (wave - 1), lds, wave, threadIdx.x & 63);
    }
    __syncthreads();
}
__global__ void __launch_bounds__(512, 2) mega_fwd(Params p) {
    extern __shared__ __attribute__((aligned(16))) unsigned char lds[];
    cg::grid_group grid = cg::this_grid();
    if (p.ph_lo < 0) grid.sync();
    volatile LAS unsigned* MISC = (volatile LAS unsigned*)((LAS unsigned char*)lds + 131072 + 320);
    if (threadIdx.x < 32) MISC[threadIdx.x] = 0u;
    __syncthreads();
    XcdBarrier bar = xcd_barrier_post((unsigned*)(p.ws + WS_CTL), MISC + 8);
    bool first = true; int kbar = 0;
    for (int ph = p.ph_lo; ph < p.ph_hi; ++ph) {
        if (!phase_exists(ph)) continue;
        if (!first) { unsigned stoff = 131072 + 320 + 32; asm volatile("" : "+s"(stoff)); bar.st = (volatile LAS unsigned*)((LAS unsigned char*)lds + stoff); ++kbar; xcd_barrier_work(bar, p, kbar, lds); }
        first = false;
        run_phase(p, ph, lds);
        __syncthreads();
    }
}

extern "C" void kernel_launch(void* const* d_in, const int* in_sizes, int n_in, void* d_out, int out_size, void* d_ws, size_t ws_size, hipStream_t stream) {
    static int grid = 0;
    if (grid == 0) {
        if (n_in != 18 || in_sizes[0] != M * D || out_size != M * D || ws_size < WS_END) { fprintf(stderr, "kernel_launch: unexpected shapes (n_in %d, in0 %d, out %d, ws %zu); nothing launched\n", n_in, n_in > 0 ? in_sizes[0] : -1, out_size, ws_size); grid = -1; return; }
        int dev = 0, cus = 0, per_cu = 0;
        if (hipGetDevice(&dev) != hipSuccess || hipDeviceGetAttribute(&cus, hipDeviceAttributeMultiprocessorCount, dev) != hipSuccess) { grid = -1; return; }
        if (hipFuncSetAttribute((const void*)mega_fwd, hipFuncAttributeMaxDynamicSharedMemorySize, LDS_BYTES) != hipSuccess) { fprintf(stderr, "kernel_launch: hipFuncSetAttribute failed\n"); grid = -1; return; }
        if (hipOccupancyMaxActiveBlocksPerMultiprocessor(&per_cu, (const void*)mega_fwd, 512, LDS_BYTES) != hipSuccess || per_cu < 1) { fprintf(stderr, "kernel_launch: occupancy query says %d\n", per_cu); per_cu = 1; }
        (void)hipGetLastError();
        grid = cus * per_cu;
    }
    if (grid < 0) return;
    if (hipMemsetAsync((char*)d_ws + WS_CTL, 0, 65536, stream) != hipSuccess) { fprintf(stderr, "kernel_launch: memset failed\n"); return; }
    Params p{};
    for (int i = 0; i < 18; ++i) p.in[i] = (const float*)d_in[i];
    p.out = (float*)d_out; p.ws = (unsigned char*)d_ws;
#if MK_ONE_LAUNCH
    p.ph_lo = 0; p.ph_hi = NPHASE;
    void* args[] = {&p};
    hipError_t e = hipLaunchCooperativeKernel((const void*)mega_fwd, dim3(grid), dim3(512), args, LDS_BYTES, stream);
    if (e != hipSuccess) fprintf(stderr, "cooperative launch failed: %s (grid %d)\n", hipGetErrorString(e), grid);
#else
    for (int ph = 0; ph < NPHASE; ++ph) {
        if (!phase_exists(ph)) continue;
        p.ph_lo = ph; p.ph_hi = ph + 1;
        hipLaunchKernelGGL(mega_fwd, dim3(grid), dim3(512), LDS_BYTES, stream, p);
    }
#endif
}
```

```cpp
#include <hip/hip_runtime.h>
#include <hip/hip_cooperative_groups.h>
#include <cstdio>
#include <cstdint>
namespace cg = cooperative_groups;
#ifndef MK_ONE_LAUNCH
#define MK_ONE_LAUNCH 1
#endif
namespace pg8 {
#define PG8_LAS __attribute__((address_space(3)))
typedef unsigned short bf16_t;
typedef short bf16x8 __attribute__((ext_vector_type(8)));
typedef float f32x4 __attribute__((ext_vector_type(4)));
typedef unsigned u32x4 __attribute__((ext_vector_type(4)));
constexpr int BM = 256, BK = 64, HALF = 128, HTB = HALF * BK * 2  , STAGE_BYTES = 8 * HTB, NXCD = 8, WGM = 8;

__host__ __device__ __forceinline__ int lds_byte(int r, int c) { const int st = (r >> 4) * 2 + (c >> 5), rr = r & 15, cc = c & 31, ob = rr * 64 + cc * 2; return st * 1024 + (ob ^ (((ob >> 9) & 1) << 5)); }
__host__ __device__ __forceinline__ void stage_rc(int b, int& R, int& C) { const int st = b / 1024, sb = b % 1024, swz = sb ^ (((sb >> 9) & 1) << 5); R = (st >> 1) * 16 + swz / 64; C = (st & 1) * 32 + (swz % 64) / 2; }
__host__ __device__ __forceinline__ int perm32(int rho) { const int n = rho >> 4, i = rho & 15; return 8 * (i >> 2) + 4 * n + (i & 3); }

struct Unit { int pm, pn; };
struct Gemm { const bf16_t* A; const bf16_t* Bt; int M, N, K; };

struct StaticOrder {
    int nM, nN, nwg, G, c, rev;
    __host__ __device__ void init(int M, int N, int G_, int c_, int rev_ = 0) { nM = M / BM; nN = N / BM; nwg = nM * nN; G = G_; c = c_; rev = rev_; }
    __host__ __device__ bool next(int i, Unit& u) const {
        const int nr = (nwg + G - 1) / G; if (i >= nr) return false;
        const long L = (long)(rev ? nr - 1 - i : i) * G + c; if (L >= nwg) return false;
        int wgid = (int)L; { const int q = nwg / NXCD, r = nwg % NXCD, xcd = wgid % NXCD, off = wgid / NXCD; wgid = (xcd < r ? xcd * (q + 1) : r * (q + 1) + (xcd - r) * q) + off; }
        const int nig = WGM * nN, gid = wgid / nig, fm = gid * WGM, gsz = (nM - fm) < WGM ? (nM - fm) : WGM;
        u.pm = fm + ((wgid % nig) % gsz); u.pn = (wgid % nig) / gsz; return true;
    }
    __device__ __forceinline__ void a_ready(const Unit&) const {}
    __device__ __forceinline__ void done(const Unit&) const {}
};
__device__ __forceinline__ unsigned cvt_pk_bf16(float lo, float hi) { unsigned r; asm volatile("v_cvt_pk_bf16_f32 %0, %1, %2" : "=v"(r) : "v"(lo), "v"(hi)); return r; }
typedef float f32x2 __attribute__((ext_vector_type(2)));
typedef unsigned u32x2 __attribute__((ext_vector_type(2)));
__device__ __forceinline__ float act_relu2(float v) { const float t = fmaxf(v, 0.f); return t * t; }
__device__ __forceinline__ float act_gelu_tanh(float v) {
    const float u = v * (0.7978845608028654f + 0.035677408136300125f * v * v);
    const float e = __builtin_amdgcn_exp2f(u * -2.885390081777927f);
    return v * __builtin_amdgcn_rcpf(1.0f + e);
}
struct EpiBf16 {
    static constexpr bool PERM = true, AFTER_DRAIN = false;
    bf16_t* O; int ldc; int act; const float* ssq;
    __device__ __forceinline__ void operator()(const f32x4 (&acc)[2][2][4][2], const Unit& u, int wr, int wc, int fr, int fq) const {
        const int row0 = u.pm * BM + wr * 64 + fr; const int col0 = u.pn * BM + wc * 32 + 8 * fq;
        f32x4 sv8[2][4]; float rs8[2][4];
#pragma unroll
        for (int ai = 0; ai < 2; ++ai)
#pragma unroll
            for (int m = 0; m < 4; ++m) sv8[ai][m] = *((const f32x4*)(ssq + (size_t)(row0 + ai * HALF + m * 16) * 16) + fq);
#pragma unroll
        for (int ai = 0; ai < 2; ++ai)
#pragma unroll
            for (int m = 0; m < 4; ++m) { float tot = (sv8[ai][m][0] + sv8[ai][m][1]) + (sv8[ai][m][2] + sv8[ai][m][3]); tot += __shfl_xor(tot, 16); tot += __shfl_xor(tot, 32);
                rs8[ai][m] = __builtin_amdgcn_rsqf(tot * (1.0f / 1024.0f) + 1e-6f); }
#pragma unroll
        for (int ai = 0; ai < 2; ++ai)
#pragma unroll
            for (int m = 0; m < 4; ++m) { const int row = row0 + ai * HALF + m * 16; bf16_t* rowp = O + (size_t)row * ldc + col0;
                const float rs = rs8[ai][m];
#pragma unroll
                for (int bj = 0; bj < 2; ++bj) { f32x4 v0 = acc[ai][bj][m][0] * rs, v1 = acc[ai][bj][m][1] * rs;
                    if (act == 1) {
#pragma unroll
                        for (int j = 0; j < 4; ++j) { v0[j] = act_relu2(v0[j]); v1[j] = act_relu2(v1[j]); }
                    } else if (act == 2) {
#pragma unroll
                        for (int j = 0; j < 4; ++j) { v0[j] = act_gelu_tanh(v0[j]); v1[j] = act_gelu_tanh(v1[j]); }
                    }
                    u32x4 w; w.x = cvt_pk_bf16(v0[0], v0[1]); w.y = cvt_pk_bf16(v0[2], v0[3]); w.z = cvt_pk_bf16(v1[0], v1[1]); w.w = cvt_pk_bf16(v1[2], v1[3]);
                    *(u32x4*)(rowp + bj * HALF) = w; } }
    }
    __device__ __forceinline__ void fused(f32x4 (&)[2][2][4][2], const Unit&, int, int, int, int, PG8_LAS unsigned char*, int, int) const {}
};
struct EpiResid {
    static constexpr bool PERM = true, AFTER_DRAIN = false;
    bf16_t* hb; float* ssq; int ldc;
    __device__ __forceinline__ void operator()(const f32x4 (&acc)[2][2][4][2], const Unit& u, int wr, int wc, int fr, int fq) const {
        const int row0 = u.pm * BM + wr * 64 + fr; const int col0 = u.pn * BM + wc * 32 + 8 * fq;
        float qv[2][4];
#pragma unroll
        for (int ai = 0; ai < 2; ++ai) {
            u32x4 bb[4][2];
#pragma unroll
            for (int m = 0; m < 4; ++m)
#pragma unroll
                for (int bj = 0; bj < 2; ++bj) bb[m][bj] = *(const u32x4*)(hb + (size_t)(row0 + ai * HALF + m * 16) * ldc + col0 + bj * HALF);
#pragma unroll
            for (int m = 0; m < 4; ++m) { const int row = row0 + ai * HALF + m * 16; bf16_t* rowp = hb + (size_t)row * ldc + col0; float q = 0.f;
#pragma unroll
                for (int bj = 0; bj < 2; ++bj) { const u32x4 b = bb[m][bj]; f32x4 v0 = acc[ai][bj][m][0], v1 = acc[ai][bj][m][1];
                    v0[0] += __uint_as_float(b.x << 16); v0[1] += __uint_as_float(b.x & 0xffff0000u); v0[2] += __uint_as_float(b.y << 16); v0[3] += __uint_as_float(b.y & 0xffff0000u);
                    v1[0] += __uint_as_float(b.z << 16); v1[1] += __uint_as_float(b.z & 0xffff0000u); v1[2] += __uint_as_float(b.w << 16); v1[3] += __uint_as_float(b.w & 0xffff0000u);
                    q += ((v0[0] * v0[0] + v0[1] * v0[1]) + (v0[2] * v0[2] + v0[3] * v0[3])) + ((v1[0] * v1[0] + v1[1] * v1[1]) + (v1[2] * v1[2] + v1[3] * v1[3]));
                    u32x4 w; w.x = cvt_pk_bf16(v0[0], v0[1]); w.y = cvt_pk_bf16(v0[2], v0[3]); w.z = cvt_pk_bf16(v1[0], v1[1]); w.w = cvt_pk_bf16(v1[2], v1[3]);
                    *(u32x4*)(rowp + bj * HALF) = w; }
                qv[ai][m] = q; }
        }
#pragma unroll
        for (int ai = 0; ai < 2; ++ai)
#pragma unroll
            for (int m = 0; m < 4; ++m) qv[ai][m] += __shfl_xor(qv[ai][m], 16);
#pragma unroll
        for (int ai = 0; ai < 2; ++ai)
#pragma unroll
            for (int m = 0; m < 4; ++m) { const float q = qv[ai][m] + __shfl_xor(qv[ai][m], 32);
                if (fq == 0) ssq[(size_t)(row0 + ai * HALF + m * 16) * 16 + u.pn * 4 + wc] = q; }
    }
    __device__ __forceinline__ void fused(f32x4 (&)[2][2][4][2], const Unit&, int, int, int, int, PG8_LAS unsigned char*, int, int) const {}
};
struct EpiAttIn {
    static constexpr bool PERM = true, AFTER_DRAIN = false;
    bf16_t* PROJ; bf16_t* VT; const float* ssq; const f32x2* r1; const f32x2* rr; const f32x2* rc; const float* qn; const float* kn;
    __device__ __forceinline__ void operator()(const f32x4 (&acc)[2][2][4][2], const Unit& u, int wr, int wc, int fr, int fq) const {
        const int pn = u.pn; const bool isB = pn >= 3; const int pt = isB ? pn - 3 : pn;
        const bool isQ = pt < 2, isV = (!isQ) && wc >= 2;
        const int row0 = u.pm * BM + wr * 64 + fr;
        const int dim0 = isB && !isV ? ((fq < 2) ? 8 * fq : 32 + 8 * (fq - 2)) : 8 * fq, dim1 = isB && !isV ? dim0 + 16 : 32 + 8 * fq;
        f32x4 g00 = {1.f, 1.f, 1.f, 1.f}, g01 = g00, g10 = g00, g11 = g00;
        if (isB && !isV) { const float* g = isQ ? qn : kn; g00 = *(const f32x4*)(g + dim0); g01 = *(const f32x4*)(g + dim0 + 4); g10 = *(const f32x4*)(g + dim1); g11 = *(const f32x4*)(g + dim1 + 4); }
        const int col = (isB ? 768 : 0) + (isQ ? 64 * (4 * pt + wc) : 512 + 64 * (wc & 1));
        f32x4 sv8[2][4]; float rs8[2][4];
#pragma unroll
        for (int ai = 0; ai < 2; ++ai)
#pragma unroll
            for (int m = 0; m < 4; ++m) sv8[ai][m] = *((const f32x4*)(ssq + (size_t)(row0 + ai * HALF + m * 16) * 16) + fq);
#pragma unroll
        for (int ai = 0; ai < 2; ++ai)
#pragma unroll
            for (int m = 0; m < 4; ++m) { float tot = (sv8[ai][m][0] + sv8[ai][m][1]) + (sv8[ai][m][2] + sv8[ai][m][3]); tot += __shfl_xor(tot, 16); tot += __shfl_xor(tot, 32);
                rs8[ai][m] = __builtin_amdgcn_rsqf(tot * (1.0f / 1024.0f) + 1e-6f); }
        bool pend = false; bf16_t* pendp = nullptr; u32x4 pw0 = {0u, 0u, 0u, 0u}, pw1 = pw0;
#pragma unroll
        for (int ai = 0; ai < 2; ++ai)
#pragma unroll
            for (int m = 0; m < 4; ++m) { const int row = row0 + ai * HALF + m * 16; const int pos = row & 8191;
                const float rs = rs8[ai][m];
                float x0[8], x1[8];
#pragma unroll
                for (int n = 0; n < 2; ++n)
#pragma unroll
                    for (int j = 0; j < 4; ++j) { x0[4 * n + j] = acc[ai][0][m][n][j] * rs; x1[4 * n + j] = acc[ai][1][m][n][j] * rs; }
                if (isV) {
                    const int b = row >> 13; bf16_t* vt = VT + ((size_t)(((b * 2 + (isB ? 1 : 0)) * 2 + (wc & 1)) * 64)) * 8192 + pos;
#pragma unroll
                    for (int e = 0; e < 8; e += 2) { const unsigned w0 = cvt_pk_bf16(x0[e], x0[e + 1]), w1 = cvt_pk_bf16(x1[e], x1[e + 1]);
                        vt[(size_t)(8 * fq + e) * 8192] = (bf16_t)(w0 & 0xffff); vt[(size_t)(8 * fq + e + 1) * 8192] = (bf16_t)(w0 >> 16);
                        vt[(size_t)(32 + 8 * fq + e) * 8192] = (bf16_t)(w1 & 0xffff); vt[(size_t)(32 + 8 * fq + e + 1) * 8192] = (bf16_t)(w1 >> 16); }
                } else {
                    const f32x2* tab = isB ? ((fq < 2) ? rr + (pos >> 6) * 16 + 8 * (fq & 1) : rc + (pos & 63) * 16 + 8 * (fq & 1)) : r1 + pos * 32 + 8 * fq;
                    f32x4 cs4[4];
#pragma unroll
                    for (int k = 0; k < 4; ++k) cs4[k] = *((const f32x4*)tab + k);
                    if (pend) { *(u32x4*)(pendp + dim0) = pw0; *(u32x4*)(pendp + dim1) = pw1; }
                    if (isB) {
                        float ss = 0.f;
#pragma unroll
                        for (int e = 0; e < 8; ++e) ss += x0[e] * x0[e] + x1[e] * x1[e];
                        ss += __shfl_xor(ss, 16); ss += __shfl_xor(ss, 32);
                        const float hn = __builtin_amdgcn_rsqf(ss * (1.0f / 64.0f) + 1e-6f);
#pragma unroll
                        for (int e = 0; e < 4; ++e) { x0[e] *= hn * g00[e]; x0[4 + e] *= hn * g01[e]; x1[e] *= hn * g10[e]; x1[4 + e] *= hn * g11[e]; }
                    }
                    const float qs = isQ ? 0.125f * 1.4426950408889634f : 1.0f;
                    float y0[8], y1[8];
#pragma unroll
                    for (int e = 0; e < 8; ++e) { const float csx = cs4[e >> 1][2 * (e & 1)], csy = cs4[e >> 1][2 * (e & 1) + 1]; y0[e] = (x0[e] * csx - x1[e] * csy) * qs; y1[e] = (x1[e] * csx + x0[e] * csy) * qs; }
                    pendp = PROJ + (size_t)row * 1536 + col; pend = true;
                    pw0.x = cvt_pk_bf16(y0[0], y0[1]); pw0.y = cvt_pk_bf16(y0[2], y0[3]); pw0.z = cvt_pk_bf16(y0[4], y0[5]); pw0.w = cvt_pk_bf16(y0[6], y0[7]);
                    pw1.x = cvt_pk_bf16(y1[0], y1[1]); pw1.y = cvt_pk_bf16(y1[2], y1[3]); pw1.z = cvt_pk_bf16(y1[4], y1[5]); pw1.w = cvt_pk_bf16(y1[6], y1[7]);
                } }
        if (pend) { *(u32x4*)(pendp + dim0) = pw0; *(u32x4*)(pendp + dim1) = pw1; }
    }
    __device__ __forceinline__ void fused(f32x4 (&)[2][2][4][2], const Unit&, int, int, int, int, PG8_LAS unsigned char*, int, int) const {}
};
template <class Epi, class Sched, bool ALIGN_EPI = false, bool SP2 = false>
__device__ __forceinline__ void gemm_phase(PG8_LAS unsigned char* lds, const Gemm g, const Sched& S, const Epi& E) {
    int tid_ = threadIdx.x; asm volatile("" : "+v"(tid_)); const int tid = tid_, wid = __builtin_amdgcn_readfirstlane(tid >> 6), lane = tid & 63, wr = wid >> 2, wc = wid & 3, fr = lane & 15, fq = lane >> 4;
    const int K = g.K, nt = K / BK;
    unsigned voffA[2], voffB[2];
#pragma unroll
    for (int i = 0; i < 2; ++i) { int R, C; stage_rc(tid * 16 + i * 8192, R, C); const int Rb = Epi::PERM ? ((R & ~31) + perm32(R & 31)) : R;
        voffA[i] = (unsigned)(R * K + C) * 2u; voffB[i] = (unsigned)(Rb * K + C) * 2u; }
    const size_t kstep = (size_t)(BK * 2);
    const size_t hstep = (size_t)HALF * K * 2;
    const size_t tstep = 2 * hstep;
    const unsigned ldsw = (unsigned)wid * 1024u;
    const int aoff = lds_byte(wr * 64 + fr, fq * 8), boff = lds_byte(wc * 32 + fr, fq * 8);
#define PG8_SA(b, h) (((b) * 2 + (h)) * HTB)
#define PG8_SB(b, h) ((4 + (b) * 2 + (h)) * HTB)
#define PG8_STAGE(bufoff, gbase, voff) do { _Pragma("unroll") for (int _i = 0; _i < 2; ++_i) \
        __builtin_amdgcn_global_load_lds((const unsigned*)((const char*)(gbase) + (voff)[_i]), (PG8_LAS unsigned*)(lds + (bufoff) + ldsw + _i * 8192), 16, 0, 0); } while (0)
#define PG8_LDA(dst, b, h) do { _Pragma("unroll") for (int m = 0; m < 4; ++m) _Pragma("unroll") for (int k = 0; k < 2; ++k) dst[m][k] = *(const PG8_LAS bf16x8*)(lds + PG8_SA(b, h) + aoff + m * 2048 + k * 1024); } while (0)
#define PG8_LDB(dst, b, h) do { _Pragma("unroll") for (int n = 0; n < 2; ++n) _Pragma("unroll") for (int k = 0; k < 2; ++k) dst[n][k] = *(const PG8_LAS bf16x8*)(lds + PG8_SB(b, h) + boff + n * 2048 + k * 1024); } while (0)
#define PG8_MMA(ai, bj, At, Bt) do { __builtin_amdgcn_s_setprio(1); _Pragma("unroll") for (int m = 0; m < 4; ++m) _Pragma("unroll") for (int n = 0; n < 2; ++n) _Pragma("unroll") for (int k = 0; k < 2; ++k) \
        acc[ai][bj][m][n] = __builtin_amdgcn_mfma_f32_16x16x32_bf16(Bt[n][k], At[m][k], acc[ai][bj][m][n], 0, 0, 0); __builtin_amdgcn_s_setprio(0); } while (0)
#define PG8_WAIT_V(n) asm volatile("s_waitcnt vmcnt(" #n ")" ::: "memory")
#define PG8_WAIT_L(n) asm volatile("s_waitcnt lgkmcnt(" #n ")" ::: "memory")
#define PG8_BAR __builtin_amdgcn_s_barrier()
#define PG8_SCHED __builtin_amdgcn_sched_barrier(0)
    Unit cur, nxt; int ui = 0;
    if (!S.next(0, cur)) return;
    f32x4 acc[2][2][4][2];
#pragma unroll
    for (int a = 0; a < 2; ++a)
#pragma unroll
        for (int b = 0; b < 2; ++b)
#pragma unroll
            for (int m = 0; m < 4; ++m)
#pragma unroll
                for (int n = 0; n < 2; ++n) acc[a][b][m][n] = (f32x4){0.f, 0.f, 0.f, 0.f};
    bf16x8 At[4][2], B0[2][2], B1[2][2];
    const char* cA = (const char*)g.A + (size_t)cur.pm * tstep; const char* cB = (const char*)g.Bt + (size_t)cur.pn * tstep;
    S.a_ready(cur);
    if constexpr (SP2) {
        PG8_STAGE(PG8_SB(0, 0), cB, voffB); PG8_STAGE(PG8_SB(0, 1), cB + hstep, voffB); PG8_STAGE(PG8_SA(0, 0), cA, voffA); PG8_STAGE(PG8_SA(0, 1), cA + hstep, voffA);
        if (wr == 1) PG8_BAR;
        PG8_WAIT_V(2); PG8_BAR;
        PG8_STAGE(PG8_SB(1, 0), cB + kstep, voffB); PG8_STAGE(PG8_SA(1, 0), cA + kstep, voffA); PG8_STAGE(PG8_SB(1, 1), cB + hstep + kstep, voffB);
        PG8_WAIT_V(6); PG8_BAR;
    } else {
        PG8_STAGE(PG8_SB(0, 0), cB, voffB); PG8_STAGE(PG8_SA(0, 0), cA, voffA); PG8_STAGE(PG8_SB(0, 1), cB + hstep, voffB); PG8_STAGE(PG8_SA(0, 1), cA + hstep, voffA);
        if (wr == 1) PG8_BAR;
        PG8_WAIT_V(4); PG8_BAR;
        PG8_STAGE(PG8_SB(1, 0), cB + kstep, voffB); PG8_STAGE(PG8_SA(1, 0), cA + kstep, voffA); PG8_STAGE(PG8_SB(1, 1), cB + hstep + kstep, voffB);
        PG8_WAIT_V(6); PG8_BAR;
    }
    for (;;) {
        const bool has_next = S.next(ui + 1, nxt);
        const char* nA = has_next ? (const char*)g.A + (size_t)nxt.pm * tstep : cA; const char* nB = has_next ? (const char*)g.Bt + (size_t)nxt.pn * tstep : cB;
        for (int t = 0; t < nt; t += 2) {
            const bool last = (t == nt - 2);
            const char* a1 = cA + (size_t)(t + 1) * kstep;
            const char* a2 = last ? nA : cA + (size_t)(t + 2) * kstep; const char* b2 = last ? nB : cB + (size_t)(t + 2) * kstep;
            const char* a3 = a2 + kstep; const char* b3 = b2 + kstep;
            if (last && has_next) S.a_ready(nxt);
            if constexpr (SP2) {
            PG8_LDB(B0, 0, 0); PG8_LDB(B1, 0, 1); PG8_SCHED; PG8_LDA(At, 0, 0); PG8_STAGE(PG8_SA(1, 1), a1 + hstep, voffA);
            PG8_WAIT_V(8); PG8_WAIT_L(0); PG8_BAR; PG8_MMA(0, 0, At, B0); PG8_MMA(0, 1, At, B1); PG8_BAR; PG8_SCHED;
            PG8_LDA(At, 0, 1); PG8_STAGE(PG8_SB(0, 0), b2, voffB); PG8_STAGE(PG8_SB(0, 1), b2 + hstep, voffB); PG8_STAGE(PG8_SA(0, 0), a2, voffA);
            PG8_WAIT_V(8); PG8_WAIT_L(0); PG8_BAR; PG8_MMA(1, 0, At, B0); PG8_MMA(1, 1, At, B1); PG8_BAR; PG8_SCHED;
            PG8_LDB(B0, 1, 0); PG8_LDB(B1, 1, 1); PG8_SCHED; PG8_LDA(At, 1, 0); PG8_STAGE(PG8_SA(0, 1), a2 + hstep, voffA);
            PG8_WAIT_V(8); PG8_WAIT_L(0); PG8_BAR; PG8_MMA(0, 0, At, B0); PG8_MMA(0, 1, At, B1); PG8_BAR; PG8_SCHED;
            PG8_LDA(At, 1, 1); PG8_STAGE(PG8_SB(1, 0), b3, voffB); PG8_STAGE(PG8_SB(1, 1), b3 + hstep, voffB); PG8_STAGE(PG8_SA(1, 0), a3, voffA);
            PG8_WAIT_V(8); PG8_WAIT_L(0); PG8_BAR; PG8_MMA(1, 0, At, B0); PG8_MMA(1, 1, At, B1); PG8_BAR; PG8_SCHED;
            } else {
            PG8_LDB(B0, 0, 0); PG8_SCHED; PG8_LDA(At, 0, 0); PG8_STAGE(PG8_SA(1, 1), a1 + hstep, voffA);
            PG8_WAIT_L(8); PG8_BAR; PG8_WAIT_L(0); PG8_MMA(0, 0, At, B0); PG8_BAR; PG8_SCHED;
            PG8_LDB(B1, 0, 1); PG8_STAGE(PG8_SB(0, 0), b2, voffB);
            PG8_BAR; PG8_WAIT_L(0); PG8_MMA(0, 1, At, B1); PG8_BAR;
            PG8_LDA(At, 0, 1); PG8_STAGE(PG8_SA(0, 0), a2, voffA);
            PG8_BAR; PG8_WAIT_L(0); PG8_MMA(1, 0, At, B0); PG8_BAR; PG8_SCHED;
            PG8_STAGE(PG8_SB(0, 1), b2 + hstep, voffB);
            PG8_WAIT_V(6); PG8_BAR; PG8_MMA(1, 1, At, B1); PG8_BAR;
            PG8_LDB(B0, 1, 0); PG8_SCHED; PG8_LDA(At, 1, 0); PG8_STAGE(PG8_SA(0, 1), a2 + hstep, voffA);
            PG8_WAIT_L(8); PG8_BAR; PG8_WAIT_L(0); PG8_MMA(0, 0, At, B0); PG8_BAR; PG8_SCHED;
            PG8_LDB(B1, 1, 1); PG8_STAGE(PG8_SB(1, 0), b3, voffB);
            PG8_BAR; PG8_WAIT_L(0); PG8_MMA(0, 1, At, B1); PG8_BAR;
            PG8_LDA(At, 1, 1); PG8_STAGE(PG8_SA(1, 0), a3, voffA);
            PG8_BAR; PG8_WAIT_L(0); PG8_MMA(1, 0, At, B0); PG8_BAR; PG8_SCHED;
            PG8_STAGE(PG8_SB(1, 1), b3 + hstep, voffB);
            PG8_WAIT_V(6); PG8_BAR; PG8_MMA(1, 1, At, B1); PG8_BAR;
            }
        }
        if constexpr (ALIGN_EPI) { if (wr == 0) PG8_BAR; }
        if constexpr (!Epi::AFTER_DRAIN) { E(acc, cur, wr, wc, fr, fq); S.done(cur); }
        if (!has_next) break;
#pragma unroll
        for (int a = 0; a < 2; ++a)
#pragma unroll
            for (int b = 0; b < 2; ++b)
#pragma unroll
                for (int m = 0; m < 4; ++m)
#pragma unroll
                    for (int n = 0; n < 2; ++n) acc[a][b][m][n] = (f32x4){0.f, 0.f, 0.f, 0.f};
        cur = nxt; cA = nA; cB = nB; ++ui;
        if constexpr (ALIGN_EPI) { if (wr == 1) PG8_BAR; }
    }
    PG8_WAIT_V(0);
    if constexpr (!ALIGN_EPI) { if (wr == 0) PG8_BAR; }
    PG8_BAR;
    if constexpr (Epi::AFTER_DRAIN) { E.fused(acc, cur, wr, wc, fr, fq, lds, wid, lane); S.done(cur); }
#undef PG8_SA
#undef PG8_SB
#undef PG8_STAGE
#undef PG8_LDA
#undef PG8_LDB
#undef PG8_MMA
#undef PG8_WAIT_V
#undef PG8_WAIT_L
#undef PG8_BAR
#undef PG8_SCHED
}
}
typedef unsigned short bf16_t;
typedef short bf16x8 __attribute__((ext_vector_type(8)));
typedef float f32x4 __attribute__((ext_vector_type(4)));
typedef float f32x16 __attribute__((ext_vector_type(16)));
typedef unsigned u32x4 __attribute__((ext_vector_type(4)));
typedef unsigned u32x2 __attribute__((ext_vector_type(2)));
typedef float f32x2_t __attribute__((ext_vector_type(2)));
typedef __bf16 bf16x2_t __attribute__((ext_vector_type(2)));

constexpr int D = 1024, BATCH = 4, SEQ = 8192, M = BATCH * SEQ, DFF = 4096, ATT_IN = 1536, SGU_IN = 2048, DEPTH = 4;
constexpr float EPS = 1e-6f, LOG2E = 1.4426950408889634f, QSCALE = 0.125f * 1.4426950408889634f;
constexpr size_t MiB = 1u << 20;
constexpr size_t WS_CTL = 0;
constexpr size_t WS_ROPE1 = 1 * MiB, WS_ROPER = 3 * MiB, WS_ROPEC = 3 * MiB + 16384, WS_WS = 3 * MiB + 512 * 1024;
constexpr size_t WS_WATT_IN = 4 * MiB, WS_WATT_OUT = 10 * MiB, WS_WSGU_IN = 14 * MiB, WS_WSGU_OUT = 22 * MiB, WS_W1 = 26 * MiB, WS_W2 = 58 * MiB;
constexpr size_t WS_XN = 90 * MiB, WS_BIG = 154 * MiB, WS_SSQ2 = 410 * MiB, WS_END = 412 * MiB;
constexpr size_t BIG_PROJ = 0, BIG_O = 96 * MiB, BIG_VT = 160 * MiB, BIG_Z = 0, BIG_Y = 128 * MiB, BIG_HID = 0;
constexpr int LDS_BYTES = 131072 + 2048;
constexpr int NPHASE = 34;

struct Params { const float* in[18]; float* out; unsigned char* ws; int ph_lo, ph_hi; };

__device__ __forceinline__ unsigned pk2(float lo, float hi) { f32x2_t v = {lo, hi}; bf16x2_t b = __builtin_convertvector(v, bf16x2_t); return __builtin_bit_cast(unsigned, b); }
__device__ __forceinline__ float bf_lo(unsigned w) { return __uint_as_float(w << 16); }
__device__ __forceinline__ float bf_hi(unsigned w) { return __uint_as_float(w & 0xffff0000u); }
__device__ __forceinline__ float bf1(bf16_t h) { return __uint_as_float(((unsigned)h) << 16); }
__device__ __forceinline__ float wave_sum(float v) {
#pragma unroll
    for (int o = 1; o < 64; o <<= 1) v += __shfl_xor(v, o);
    return v;
}
#define MFMA32(a, b, c) __builtin_amdgcn_mfma_f32_32x32x16_bf16((a), (b), (c), 0, 0, 0)

__device__ __forceinline__ int att_remap(int n) {
    const int pn = n >> 8, hq = (n >> 6) & 3, dl = n & 63; int bj, s;
    if (pn >= 3 && !(pn == 5 && hq >= 2)) { if (dl < 16) { bj = 0; s = dl; } else if (dl < 32) { bj = 1; s = dl - 16; } else if (dl < 48) { bj = 0; s = dl - 16; } else { bj = 1; s = dl - 32; } }
    else { bj = dl >> 5; s = dl & 31; }
    return 256 * pn + 128 * bj + 32 * hq + s;
}
__device__ __forceinline__ void transpose_load(float (&v)[32], const float* W, int N, int item, int lane) {
    const int nblk = N / 32, kb = item / nblk, nb = item % nblk, k0 = 64 * kb, n0 = 32 * nb;
    const float* src = W + (size_t)(k0 + (lane >> 5)) * N + n0 + (lane & 31);
#pragma unroll
    for (int i = 0; i < 32; ++i) v[i] = src[(size_t)(2 * i) * N];
}
__device__ __forceinline__ void transpose_store(const float (&v)[32], int K, int N, const float* gain, bf16_t* WT, float* scr, int item, int lane, bool remap) {
    const int nblk = N / 32, kb = item / nblk, nb = item % nblk, k0 = 64 * kb, n0 = 32 * nb;
    const int c = lane & 7;
    f32x4 g0 = {1.f, 1.f, 1.f, 1.f}, g1 = g0;
    if (gain) { g0 = *(const f32x4*)(gain + k0 + 8 * c); g1 = *(const f32x4*)(gain + k0 + 8 * c + 4); }
#pragma unroll
    for (int i = 0; i < 32; ++i) scr[(2 * i + (lane >> 5)) * 33 + (lane & 31)] = v[i];
    asm volatile("s_waitcnt lgkmcnt(0)" ::: "memory");
#pragma unroll
    for (int j = 0; j < 4; ++j) { const int n = (lane >> 3) + 8 * j; const float* s = scr + (8 * c) * 33 + n;
        u32x4 o; o.x = pk2(s[0 * 33] * g0[0], s[1 * 33] * g0[1]); o.y = pk2(s[2 * 33] * g0[2], s[3 * 33] * g0[3]); o.z = pk2(s[4 * 33] * g1[0], s[5 * 33] * g1[1]); o.w = pk2(s[6 * 33] * g1[2], s[7 * 33] * g1[3]);
        const int nrow = remap ? att_remap(n0 + n) : n0 + n;
        *(u32x4*)(WT + (size_t)nrow * K + k0 + 8 * c) = o; }
    asm volatile("s_waitcnt lgkmcnt(0)" ::: "memory");
}
__device__ __forceinline__ void phase_prologue(const Params& p, unsigned char* lds) {
    int tid_ = threadIdx.x; asm volatile("" : "+v"(tid_)); const int tid = tid_, lane = tid & 63, wave = tid >> 6;
    const int gw = blockIdx.x * 8 + wave, ngw = gridDim.x * 8;
    float* scr = (float*)(lds + wave * 16384);
    const int nmat = (gridDim.x == 256) ? 1 : 16;
    for (int mi = 0; mi < nmat; ++mi) {
        const float* W; const float* gain = nullptr; bf16_t* WT; int K = D, N;
        if (mi < 2)       { W = p.in[2] + (size_t)mi * D * ATT_IN; gain = p.in[1] + mi * D; N = ATT_IN; WT = (bf16_t*)(p.ws + WS_WATT_IN) + (size_t)mi * ATT_IN * D; }
        else if (mi < 4)  { const int i = mi - 2; W = p.in[6] + (size_t)i * D * D; N = D; WT = (bf16_t*)(p.ws + WS_WATT_OUT) + (size_t)i * D * D; }
        else if (mi < 6)  { const int i = mi - 4; W = p.in[8] + (size_t)i * D * SGU_IN; gain = p.in[7] + i * D; N = SGU_IN; WT = (bf16_t*)(p.ws + WS_WSGU_IN) + (size_t)i * SGU_IN * D; }
        else if (mi < 8)  { const int i = mi - 6; W = p.in[13] + (size_t)i * D * D; N = D; WT = (bf16_t*)(p.ws + WS_WSGU_OUT) + (size_t)i * D * D; }
        else if (mi < 12) { const int i = mi - 8; W = p.in[15] + (size_t)i * D * DFF; gain = p.in[14] + i * D; N = DFF; WT = (bf16_t*)(p.ws + WS_W1) + (size_t)i * DFF * D; }
        else              { const int i = mi - 12; W = p.in[16] + (size_t)i * DFF * D; K = DFF; N = D; WT = (bf16_t*)(p.ws + WS_W2) + (size_t)i * D * DFF; }
        const int items = (K / 64) * (N / 32);
        float va[32], vb[32];
        int it = gw;
        if (it < items) transpose_load(va, W, N, it, lane);
        for (; it < items; it += 2 * ngw) {
            const int it1 = it + ngw, it2 = it + 2 * ngw;
            if (it1 < items) transpose_load(vb, W, N, it1, lane);
            transpose_store(va, K, N, gain, WT, scr, it, lane, mi < 2);
            if (it2 < items) transpose_load(va, W, N, it2, lane);
            if (it1 < items) transpose_store(vb, K, N, gain, WT, scr, it1, lane, mi < 2);
        }
    }
    { const float* src = p.in[11]; bf16_t* dst = (bf16_t*)(p.ws + WS_WS); const int n4 = 2 * 8 * 128 * 128 / 4;
      for (int i = blockIdx.x * 512 + tid; i < n4; i += gridDim.x * 512) { const f32x4 v = *(const f32x4*)(src + 4 * (size_t)i); u32x2 o; o.x = pk2(v[0], v[1]); o.y = pk2(v[2], v[3]); *(u32x2*)(dst + 4 * (size_t)i) = o; } }
    { f32x2_t* r1 = (f32x2_t*)(p.ws + WS_ROPE1); f32x2_t* rr = (f32x2_t*)(p.ws + WS_ROPER); f32x2_t* rc = (f32x2_t*)(p.ws + WS_ROPEC);
      const int total = SEQ * 32 + 128 * 16 + 64 * 16;
      for (int i = blockIdx.x * 512 + tid; i < total; i += gridDim.x * 512) {
          int pos, fi; float fexp; f32x2_t* dst;
          if (i < SEQ * 32) { pos = i >> 5; fi = i & 31; fexp = (float)fi * (1.0f / 32.0f); dst = r1 + i; }
          else if (i < SEQ * 32 + 128 * 16) { const int j = i - SEQ * 32; pos = j >> 4; fi = j & 15; fexp = (float)fi * (1.0f / 16.0f); dst = rr + j; }
          else { const int j = i - SEQ * 32 - 128 * 16; pos = j >> 4; fi = j & 15; fexp = (float)fi * (1.0f / 16.0f); dst = rc + j; }
          const float freq = exp2f(-fexp * 13.287712379549449f);
          const float ang = (float)pos * freq;
          float tr = ang * 0.15915494309189535f; tr = tr - floorf(tr);
          const float sn = __builtin_amdgcn_sinf(tr), cs = __builtin_amdgcn_cosf(tr);
          *dst = (f32x2_t){cs, sn};
      } }
}

constexpr int DEFER_TOTAL = 512 + 2048 + 2048 + 1024 + 512 + 2048 + 2048 + 768 + 512 + 2048 + 2048 + 1024 + 512 + 2048 + 2048;
__device__ __forceinline__ void deferred_convert_item(const Params& p, int g, unsigned char* lds, int wave, int lane) {
    if (g >= DEFER_TOTAL) return;
    const float* W; const float* gain = nullptr; bf16_t* WT; int K = D, N = D; bool remap = false; int r = g;
    int kind, idx;
    if (r < 512) { kind = 0; idx = 0; } else if ((r -= 512) < 2048) { kind = 1; idx = 0; } else if ((r -= 2048) < 2048) { kind = 2; idx = 0; }
    else if ((r -= 2048) < 1024) { kind = 3; idx = 0; } else if ((r -= 1024) < 512) { kind = 4; idx = 0; } else if ((r -= 512) < 2048) { kind = 1; idx = 1; }
    else if ((r -= 2048) < 2048) { kind = 2; idx = 1; } else if ((r -= 2048) < 768) { kind = 5; idx = 1; } else if ((r -= 768) < 512) { kind = 0; idx = 1; }
    else if ((r -= 512) < 2048) { kind = 1; idx = 2; } else if ((r -= 2048) < 2048) { kind = 2; idx = 2; } else if ((r -= 2048) < 1024) { kind = 3; idx = 1; }
    else if ((r -= 1024) < 512) { kind = 4; idx = 1; } else if ((r -= 512) < 2048) { kind = 1; idx = 3; } else { r -= 2048; kind = 2; idx = 3; }
    if (kind == 0)      { W = p.in[6] + (size_t)idx * D * D; WT = (bf16_t*)(p.ws + WS_WATT_OUT) + (size_t)idx * D * D; }
    else if (kind == 1) { W = p.in[15] + (size_t)idx * D * DFF; gain = p.in[14] + idx * D; N = DFF; WT = (bf16_t*)(p.ws + WS_W1) + (size_t)idx * DFF * D; }
    else if (kind == 2) { W = p.in[16] + (size_t)idx * DFF * D; K = DFF; WT = (bf16_t*)(p.ws + WS_W2) + (size_t)idx * D * DFF; }
    else if (kind == 3) { W = p.in[8] + (size_t)idx * D * SGU_IN; gain = p.in[7] + idx * D; N = SGU_IN; WT = (bf16_t*)(p.ws + WS_WSGU_IN) + (size_t)idx * SGU_IN * D; }
    else if (kind == 4) { W = p.in[13] + (size_t)idx * D * D; WT = (bf16_t*)(p.ws + WS_WSGU_OUT) + (size_t)idx * D * D; }
    else                { W = p.in[2] + (size_t)idx * D * ATT_IN; gain = p.in[1] + idx * D; N = ATT_IN; WT = (bf16_t*)(p.ws + WS_WATT_IN) + (size_t)idx * ATT_IN * D; remap = true; }
    float v[32];
    transpose_load(v, W, N, r, lane);
    transpose_store(v, K, N, gain, WT, (float*)(lds + wave * 16384), r, lane, remap);
}
__device__ __forceinline__ void phase_cast_x(const float* src, bf16_t* dst, float* ssq) {
    int tid_ = threadIdx.x; asm volatile("" : "+v"(tid_)); const int tid = tid_, lane = tid & 63, wave = tid >> 6;
    const int gw = blockIdx.x * 8 + wave, ngw = gridDim.x * 8;
    for (int m0 = gw; m0 < M; m0 += 4 * ngw) {
        f32x4 v[4][4];
#pragma unroll
        for (int rr = 0; rr < 4; ++rr) { const int m = m0 + rr * ngw; if (m < M) { const f32x4* xr = (const f32x4*)(src + (size_t)m * D) + lane;
#pragma unroll
            for (int j = 0; j < 4; ++j) v[rr][j] = xr[64 * j]; } }
#pragma unroll
        for (int rr = 0; rr < 4; ++rr) { const int m = m0 + rr * ngw; if (m < M) { float s = 0.f;
#pragma unroll
            for (int j = 0; j < 4; ++j) s += (v[rr][j][0] * v[rr][j][0] + v[rr][j][1] * v[rr][j][1]) + (v[rr][j][2] * v[rr][j][2] + v[rr][j][3] * v[rr][j][3]);
            s = wave_sum(s);
            u32x2* o8 = (u32x2*)(dst + (size_t)m * D) + lane;
#pragma unroll
            for (int j = 0; j < 4; ++j) { u32x2 o; o.x = pk2(v[rr][j][0], v[rr][j][1]); o.y = pk2(v[rr][j][2], v[rr][j][3]); o8[64 * j] = o; }
            if (lane < 16) ssq[(size_t)m * 16 + lane] = lane == 0 ? s : 0.f; } }
    }
}
__device__ __forceinline__ void phase_norm(const float* src, bf16_t* dst) {
    int tid_ = threadIdx.x; asm volatile("" : "+v"(tid_)); const int tid = tid_, lane = tid & 63, wave = tid >> 6;
    const int gw = blockIdx.x * 8 + wave, ngw = gridDim.x * 8;
    for (int m = gw; m < M; m += ngw) {
        const f32x4* xr = (const f32x4*)(src + (size_t)m * D) + lane;
        f32x4 v[4]; float s = 0.f;
#pragma unroll
        for (int j = 0; j < 4; ++j) { v[j] = xr[64 * j]; s += (v[j][0] * v[j][0] + v[j][1] * v[j][1]) + (v[j][2] * v[j][2] + v[j][3] * v[j][3]); }
        const float rs = rsqrtf(wave_sum(s) * (1.0f / D) + EPS);
        u32x2* o8 = (u32x2*)(dst + (size_t)m * D) + lane;
#pragma unroll
        for (int j = 0; j < 4; ++j) { u32x2 o; o.x = pk2(v[j][0] * rs, v[j][1] * rs); o.y = pk2(v[j][2] * rs, v[j][3] * rs); o8[64 * j] = o; }
    }
}
__device__ __forceinline__ void phase_final_norm(const bf16_t* hb, float* out, const float* g) {
    int tid_ = threadIdx.x; asm volatile("" : "+v"(tid_)); const int tid = tid_, lane = tid & 63, wave = tid >> 6;
    const int gw = blockIdx.x * 8 + wave, ngw = gridDim.x * 8;
    f32x4 gg[4];
#pragma unroll
    for (int j = 0; j < 4; ++j) gg[j] = *((const f32x4*)g + lane + 64 * j);
    for (int m0 = gw; m0 < M; m0 += 4 * ngw) {
        u32x2 raw[4][4];
#pragma unroll
        for (int rr = 0; rr < 4; ++rr) { const int m = m0 + rr * ngw; if (m < M) { const u32x2* xr = (const u32x2*)(hb + (size_t)m * D) + lane;
#pragma unroll
            for (int j = 0; j < 4; ++j) raw[rr][j] = xr[64 * j]; } }
#pragma unroll
        for (int rr = 0; rr < 4; ++rr) { const int m = m0 + rr * ngw; if (m < M) { f32x4 v[4]; float s = 0.f;
#pragma unroll
            for (int j = 0; j < 4; ++j) { const u32x2 r = raw[rr][j]; v[j] = (f32x4){bf_lo(r.x), bf_hi(r.x), bf_lo(r.y), bf_hi(r.y)}; s += (v[j][0] * v[j][0] + v[j][1] * v[j][1]) + (v[j][2] * v[j][2] + v[j][3] * v[j][3]); }
            const float rs = rsqrtf(wave_sum(s) * (1.0f / D) + EPS);
            f32x4* o = (f32x4*)(out + (size_t)m * D) + lane;
#pragma unroll
            for (int j = 0; j < 4; ++j) o[64 * j] = v[j] * rs * gg[j]; } }
    }
}

__device__ __forceinline__ void phase_prep(const Params& p, int li) {
    int tid_ = threadIdx.x; asm volatile("" : "+v"(tid_)); const int tid = tid_, lane = tid & 63, wave = tid >> 6;
    bf16_t* PROJ = (bf16_t*)(p.ws + WS_BIG + BIG_PROJ); bf16_t* VT = (bf16_t*)(p.ws + WS_BIG + BIG_VT);
    const f32x2_t* r1 = (const f32x2_t*)(p.ws + WS_ROPE1); const f32x2_t* rr = (const f32x2_t*)(p.ws + WS_ROPER); const f32x2_t* rc = (const f32x2_t*)(p.ws + WS_ROPEC);
    const float* qn = p.in[4] + li * 64; const float* kn = p.in[5] + li * 64;
    for (int tt = blockIdx.x; tt < M / 64; tt += gridDim.x) {
        const int b = tt >> 7, s0 = (tt & 127) * 64;
        const int tok = tid >> 3, j = tid & 7; const int pos = s0 + tok; const size_t row = (size_t)tt * 64 + tok;
#pragma unroll 5
        for (int hs = 0; hs < 20; ++hs) {
            const bool isB = hs >= 10; const int h2 = isB ? hs - 10 : hs; const bool isQ = h2 < 8;
            const int col = (isB ? 768 : 0) + (isQ ? 64 * h2 : 512 + 64 * (h2 - 8));
            bf16_t* ptr = PROJ + row * ATT_IN + col + 8 * j;
            const u32x4 raw = *(const u32x4*)ptr;
            float x[8]; x[0] = bf_lo(raw.x); x[1] = bf_hi(raw.x); x[2] = bf_lo(raw.y); x[3] = bf_hi(raw.y); x[4] = bf_lo(raw.z); x[5] = bf_hi(raw.z); x[6] = bf_lo(raw.w); x[7] = bf_hi(raw.w);
            float y[8];
            if (!isB) {
#pragma unroll
                for (int e = 0; e < 8; ++e) { const float pr = __shfl_xor(x[e], 4); const f32x2_t cs = r1[pos * 32 + 8 * (j & 3) + e]; y[e] = x[e] * cs.x + ((j < 4) ? -pr : pr) * cs.y; }
            } else {
                float ss = 0.f;
#pragma unroll
                for (int e = 0; e < 8; ++e) ss += x[e] * x[e];
                ss += __shfl_xor(ss, 1); ss += __shfl_xor(ss, 2); ss += __shfl_xor(ss, 4);
                const float rs = rsqrtf(ss * (1.0f / 64.0f) + EPS); const float* gn = isQ ? qn : kn;
#pragma unroll
                for (int e = 0; e < 8; ++e) x[e] = x[e] * rs * gn[8 * j + e];
                const f32x2_t* tab = (j < 4) ? (rr + (pos >> 6) * 16) : (rc + (pos & 63) * 16);
#pragma unroll
                for (int e = 0; e < 8; ++e) { const float pr = __shfl_xor(x[e], 2); const f32x2_t cs = tab[8 * (j & 1) + e]; y[e] = x[e] * cs.x + ((j & 2) ? pr : -pr) * cs.y; }
            }
            if (isQ) {
#pragma unroll
                for (int e = 0; e < 8; ++e) y[e] *= QSCALE;
            }
            u32x4 o; o.x = pk2(y[0], y[1]); o.y = pk2(y[2], y[3]); o.z = pk2(y[4], y[5]); o.w = pk2(y[6], y[7]);
            *(u32x4*)ptr = o;
        }
#pragma unroll
        for (int i = 0; i < 4; ++i) {
            const int vcol = (wave * 4 + i) * 8; const int type = vcol >> 7, kvh = (vcol >> 6) & 1, d0 = vcol & 63;
            const int col = (type ? 1408 : 640) + kvh * 64 + d0;
            const u32x4 raw = *(const u32x4*)(PROJ + ((size_t)tt * 64 + lane) * ATT_IN + col);
            bf16_t* vt = VT + ((size_t)(((b * 2 + type) * 2 + kvh) * 64 + d0)) * SEQ + s0 + lane;
            vt[0 * SEQ] = (bf16_t)(raw.x & 0xffff); vt[1 * SEQ] = (bf16_t)(raw.x >> 16); vt[2 * SEQ] = (bf16_t)(raw.y & 0xffff); vt[3 * SEQ] = (bf16_t)(raw.y >> 16);
            vt[4 * SEQ] = (bf16_t)(raw.z & 0xffff); vt[5 * SEQ] = (bf16_t)(raw.z >> 16); vt[6 * SEQ] = (bf16_t)(raw.w & 0xffff); vt[7 * SEQ] = (bf16_t)(raw.w >> 16);
        }
    }
}

constexpr int KSTR = 144;
__device__ __forceinline__ float max3f(float a, float b, float c) { float r; asm("v_max3_f32 %0, %1, %2, %3" : "=v"(r) : "v"(a), "v"(b), "v"(c)); return r; }
__device__ __forceinline__ float max2f(float a, float b) { float r; asm("v_max_f32_e32 %0, %1, %2" : "=v"(r) : "v"(a), "v"(b)); return r; }
constexpr float ATT_THR = 10.0f;
__device__ __forceinline__ void qk_tile(f32x16& p0, f32x16& p1, const unsigned char* kb, const bf16x8 (&qr)[4], float cinit) {
#pragma unroll
    for (int r = 0; r < 16; ++r) { p0[r] = cinit; p1[r] = cinit; }
#pragma unroll
    for (int d0 = 0; d0 < 4; ++d0) {
        const bf16x8 a0 = *(const bf16x8*)(kb + d0 * 32), a1 = *(const bf16x8*)(kb + 32 * KSTR + d0 * 32);
        p0 = MFMA32(a0, qr[d0], p0); p1 = MFMA32(a1, qr[d0], p1);
    }
}
__device__ __forceinline__ void band_mask(f32x16& p0, f32x16& p1, int kb0) {
#pragma unroll
    for (int r = 0; r < 16; ++r) { const int dk = kb0 + (r & 3) + 8 * (r >> 2);
        if (dk > 128 || dk < -128) p0[r] = -INFINITY;
        if (dk + 32 > 128 || dk + 32 < -128) p1[r] = -INFINITY; }
}
#define SGB(mask, n) __builtin_amdgcn_sched_group_barrier(mask, n, 0)
__device__ __forceinline__ float sum16(const f32x16& x) {
    float r;
    asm("s_nop 1\n\tv_add_f32_e32 %0, %1, %2\n\tv_add_f32_e32 %0, %0, %3\n\tv_add_f32_e32 %0, %0, %4\n\tv_add_f32_e32 %0, %0, %5\n\tv_add_f32_e32 %0, %0, %6\n\tv_add_f32_e32 %0, %0, %7\n\tv_add_f32_e32 %0, %0, %8\n\t"
        "v_add_f32_e32 %0, %0, %9\n\tv_add_f32_e32 %0, %0, %10\n\tv_add_f32_e32 %0, %0, %11\n\tv_add_f32_e32 %0, %0, %12\n\tv_add_f32_e32 %0, %0, %13\n\tv_add_f32_e32 %0, %0, %14\n\tv_add_f32_e32 %0, %0, %15\n\tv_add_f32_e32 %0, %0, %16"
        : "=&v"(r) : "v"(x[0]), "v"(x[1]), "v"(x[2]), "v"(x[3]), "v"(x[4]), "v"(x[5]), "v"(x[6]), "v"(x[7]), "v"(x[8]), "v"(x[9]), "v"(x[10]), "v"(x[11]), "v"(x[12]), "v"(x[13]), "v"(x[14]), "v"(x[15]));
    return r;
}
template <int TYPE>
__device__ __forceinline__ void attn_soft(f32x16& sA, f32x16& sB, int kb0, float& tsum, u32x4 (&pw)[4]) {
    if (TYPE == 0) band_mask(sA, sB, kb0);
#pragma unroll
    for (int r = 0; r < 16; ++r) { sA[r] = __builtin_amdgcn_exp2f(sA[r]); sB[r] = __builtin_amdgcn_exp2f(sB[r]); }
    tsum = sum16(sA) + sum16(sB);
#pragma unroll
    for (int s = 0; s < 2; ++s) {
        pw[s]     = (u32x4){pk2(sA[8 * s], sA[8 * s + 1]), pk2(sA[8 * s + 2], sA[8 * s + 3]), pk2(sA[8 * s + 4], sA[8 * s + 5]), pk2(sA[8 * s + 6], sA[8 * s + 7])};
        pw[2 + s] = (u32x4){pk2(sB[8 * s], sB[8 * s + 1]), pk2(sB[8 * s + 2], sB[8 * s + 3]), pk2(sB[8 * s + 4], sB[8 * s + 5]), pk2(sB[8 * s + 6], sB[8 * s + 7])};
    }
}
struct AttnState2 { float mrun[2]; float lrun[2]; f32x16 o[2][2]; };
template <int TYPE>
__device__ __forceinline__ void attn_step2(AttnState2& st, const bf16x8 (&qr)[2][4], const unsigned char* kb, const unsigned char* vb, int kb0) {
    bf16x8 kf[8];
#pragma unroll
    for (int d0 = 0; d0 < 4; ++d0) { kf[2 * d0] = *(const bf16x8*)(kb + d0 * 32); kf[2 * d0 + 1] = *(const bf16x8*)(kb + 32 * KSTR + d0 * 32); }
    __builtin_amdgcn_sched_barrier(0);
    f32x16 s00, s01, s10, s11;
    { f32x16 z, z1;
#pragma unroll
      for (int r = 0; r < 16; ++r) { z[r] = 0.f; z1[r] = 0.f; }
      s00 = MFMA32(kf[0], qr[0][0], z); s01 = MFMA32(kf[1], qr[0][0], z);
#pragma unroll
      for (int d0 = 1; d0 < 4; ++d0) { s00 = MFMA32(kf[2 * d0], qr[0][d0], s00); s01 = MFMA32(kf[2 * d0 + 1], qr[0][d0], s01); }
      s10 = MFMA32(kf[0], qr[1][0], z1); s11 = MFMA32(kf[1], qr[1][0], z1);
#pragma unroll
      for (int d0 = 1; d0 < 4; ++d0) { s10 = MFMA32(kf[2 * d0], qr[1][d0], s10); s11 = MFMA32(kf[2 * d0 + 1], qr[1][d0], s11); } }
    bf16x8 vf[8];
#pragma unroll
    for (int c = 0; c < 4; ++c) { vf[2 * c] = *(const bf16x8*)(vb + c * 32); vf[2 * c + 1] = *(const bf16x8*)(vb + 32 * KSTR + c * 32); }
    if (__any(st.mrun[0] != 0.0f || st.mrun[1] != 0.0f)) {
#pragma unroll
        for (int r = 0; r < 16; ++r) { s00[r] -= st.mrun[0]; s01[r] -= st.mrun[0]; s10[r] -= st.mrun[1]; s11[r] -= st.mrun[1]; }
    }
    float pm0, pm1; u32x4 pw0[4], pw1[4];
    attn_soft<TYPE>(s00, s01, kb0, pm0, pw0);
#pragma unroll
    for (int c = 0; c < 4; ++c) { const bf16x8 pf = __builtin_bit_cast(bf16x8, pw0[c]); st.o[0][0] = MFMA32(vf[2 * c], pf, st.o[0][0]); st.o[0][1] = MFMA32(vf[2 * c + 1], pf, st.o[0][1]); }
    attn_soft<TYPE>(s10, s11, kb0 - 32, pm1, pw1);
#pragma unroll
    for (int c = 0; c < 4; ++c) { const bf16x8 pf = __builtin_bit_cast(bf16x8, pw1[c]); st.o[1][0] = MFMA32(vf[2 * c], pf, st.o[1][0]); st.o[1][1] = MFMA32(vf[2 * c + 1], pf, st.o[1][1]); }
#pragma unroll
    for (int k = 0; k < 8; ++k) SGB(0x008, 1);
#pragma unroll
    for (int k = 0; k < 8; ++k) { SGB(0x008, 1); SGB(0x002, 6); }
    SGB(0x100, 8);
#pragma unroll
    for (int k = 0; k < 8; ++k) { SGB(0x008, 1); SGB(0x002, 8); }
    __builtin_amdgcn_sched_barrier(0);
    st.lrun[0] += pm0; st.lrun[1] += pm1;
    if (__any(pm0 > 1024.0f || pm1 > 1024.0f)) {
        const float r0 = pm0 + __shfl_xor(pm0, 32), r1 = pm1 + __shfl_xor(pm1, 32);
        const float d0 = r0 > 1024.0f ? __builtin_amdgcn_logf(r0) : 0.0f, d1 = r1 > 1024.0f ? __builtin_amdgcn_logf(r1) : 0.0f;
        const float a0 = __builtin_amdgcn_exp2f(-d0), a1 = __builtin_amdgcn_exp2f(-d1);
#pragma unroll
        for (int r = 0; r < 16; ++r) { st.o[0][0][r] *= a0; st.o[0][1][r] *= a0; st.o[1][0][r] *= a1; st.o[1][1][r] *= a1; }
        st.lrun[0] *= a0; st.lrun[1] *= a1; st.mrun[0] += d0; st.mrun[1] += d1;
    }
}
template <int TYPE>
__device__ __forceinline__ void attn_unit(unsigned char* lds, const bf16_t* PROJ, const bf16_t* VT, bf16_t* O, const float* sink, int b, int kvh, int qt) {
    constexpr int type = TYPE;
    int tid_ = threadIdx.x; asm volatile("" : "+v"(tid_)); const int tid = tid_, lane = tid & 63, w = tid >> 6, r32 = lane & 31, hi = lane >> 5;
    const int hg = w >> 1, rh = w & 1, qhead = kvh * 4 + hg;
    const int qcol = (type ? 768 : 0) + 64 * qhead, kcol = (type ? 1280 : 512) + 64 * kvh;
    const size_t rowbase = (size_t)b * SEQ;
    const int qpos0 = qt * 128 + 64 * rh + r32;
    bf16x8 qr[2][4];
#pragma unroll
    for (int blk = 0; blk < 2; ++blk) { const bf16_t* qp = PROJ + (rowbase + qpos0 + 32 * blk) * ATT_IN + qcol + 8 * hi;
#pragma unroll
      for (int d0 = 0; d0 < 4; ++d0) qr[blk][d0] = *(const bf16x8*)(qp + 16 * d0); }
    int t_lo = 0, t_hi = SEQ / 64 - 1;
    if (type == 0) { t_lo = 2 * qt - 2 < 0 ? 0 : 2 * qt - 2; t_hi = 2 * qt + 3 > SEQ / 64 - 1 ? SEQ / 64 - 1 : 2 * qt + 3; }
    const int n = t_hi - t_lo + 1;
    const int srow = tid >> 3, sch = tid & 7;
    const bf16_t* kg = PROJ + (rowbase + (size_t)t_lo * 64 + srow) * ATT_IN + kcol + 8 * sch;
    const bf16_t* vg = VT + ((size_t)(((b * 2 + type) * 2 + kvh) * 64 + srow)) * SEQ + t_lo * 64 + 8 * sch;
    unsigned char* Ks = lds; unsigned char* Vs = lds + 2 * 64 * KSTR;
    const int ksoff = srow * KSTR + sch * 16;
    const int vsoff = srow * KSTR + (sch >> 1) * 32 + (sch & 1) * 8;
    const int foff = r32 * KSTR + hi * 16;
    { const u32x4 k0 = *(const u32x4*)kg, v0 = *(const u32x4*)vg;
      *(u32x4*)(Ks + ksoff) = k0; *(u32x2*)(Vs + vsoff) = (u32x2){v0.x, v0.y}; *(u32x2*)(Vs + vsoff + 16) = (u32x2){v0.z, v0.w}; }
    __syncthreads();
    AttnState2 st;
    const float l0 = (type == 0 && hi == 0) ? __builtin_amdgcn_exp2f(sink[qhead] * LOG2E) : 0.0f;
#pragma unroll
    for (int blk = 0; blk < 2; ++blk) { st.mrun[blk] = 0.0f; st.lrun[blk] = l0;
#pragma unroll
        for (int r = 0; r < 16; ++r) { st.o[blk][0][r] = 0.f; st.o[blk][1][r] = 0.f; } }
    for (int i = 0; i < n; ++i) {
        u32x4 kreg, vreg;
        { const int i1 = i + 1 < n ? i + 1 : i; kreg = *(const u32x4*)(kg + (size_t)i1 * 64 * ATT_IN); vreg = *(const u32x4*)(vg + i1 * 64); }
        const unsigned char* kb = Ks + (i & 1) * 64 * KSTR + foff; const unsigned char* vb = Vs + (i & 1) * 64 * KSTR + foff;
        const int kb0 = (t_lo + i) * 64 + 4 * hi - qpos0;
        attn_step2<TYPE>(st, qr, kb, vb, kb0);
        { const int nb = ((i + 1) & 1) * 64 * KSTR;
          *(u32x4*)(Ks + nb + ksoff) = kreg; *(u32x2*)(Vs + nb + vsoff) = (u32x2){vreg.x, vreg.y}; *(u32x2*)(Vs + nb + vsoff + 16) = (u32x2){vreg.z, vreg.w}; }
        __syncthreads();
    }
    int tid2 = threadIdx.x; asm volatile("" : "+v"(tid2));
    const int lane2 = tid2 & 63, w2 = tid2 >> 6;
#pragma unroll
    for (int blk = 0; blk < 2; ++blk) {
        const float lsum = st.lrun[blk];
        const float inv = 1.0f / (lsum + __shfl_xor(lsum, 32));
        bf16_t* op = O + ((size_t)b * SEQ + qt * 128 + 64 * (w2 & 1) + 32 * blk + (lane2 & 31)) * D + (type ? 512 : 0) + 64 * (kvh * 4 + (w2 >> 1)) + ((lane2 >> 5) ? 0 : 16);
#pragma unroll
        for (int half = 0; half < 2; ++half) {
            unsigned px[4], py[4];
#pragma unroll
            for (int gq = 0; gq < 4; ++gq) { px[gq] = pk2(st.o[blk][half][4 * gq] * inv, st.o[blk][half][4 * gq + 1] * inv); py[gq] = pk2(st.o[blk][half][4 * gq + 2] * inv, st.o[blk][half][4 * gq + 3] * inv); }
#pragma unroll
            for (int j = 0; j < 2; ++j) {
                const auto sx = __builtin_amdgcn_permlane32_swap(px[2 + j], px[j], false, false);
                const auto sy = __builtin_amdgcn_permlane32_swap(py[2 + j], py[j], false, false);
                *(u32x4*)(op + 32 * half + 8 * j) = (u32x4){sx[0], sy[0], sx[1], sy[1]};
            }
        }
    }
}
__device__ __forceinline__ void phase_attn(const Params& p, int li, unsigned char* lds) {
    const bf16_t* PROJ = (const bf16_t*)(p.ws + WS_BIG + BIG_PROJ); const bf16_t* VT = (const bf16_t*)(p.ws + WS_BIG + BIG_VT); bf16_t* O = (bf16_t*)(p.ws + WS_BIG + BIG_O);
    const float* sink = p.in[3] + li * 8;
    if (gridDim.x == 256) {
        const int bk = blockIdx.x & 7, idx = blockIdx.x >> 3;
        for (int i = 0; i < 2; ++i) attn_unit<1>(lds, PROJ, VT, O, sink, bk >> 1, bk & 1, 32 * i + idx);
        for (int i = 0; i < 2; ++i) attn_unit<0>(lds, PROJ, VT, O, sink, bk >> 1, bk & 1, 32 * i + idx);
    } else {
        for (int u = blockIdx.x; u < 1024; u += gridDim.x) {
            const int v = u & 511; const int qt = v & 63, bk = v >> 6;
            if (u < 512) attn_unit<1>(lds, PROJ, VT, O, sink, bk >> 1, bk & 1, qt); else attn_unit<0>(lds, PROJ, VT, O, sink, bk >> 1, bk & 1, qt);
        }
    }
}

constexpr int VSTR = 272;
__device__ __forceinline__ void phase_sgu_mix(const Params& p, int li, unsigned char* lds) {
    int tid_ = threadIdx.x; asm volatile("" : "+v"(tid_)); const int tid = tid_, lane = tid & 63, w = tid >> 6, r32 = lane & 31, hi = lane >> 5;
    const bf16_t* Z = (const bf16_t*)(p.ws + WS_BIG + BIG_Z); bf16_t* Y = (bf16_t*)(p.ws + WS_BIG + BIG_Y);
    const bf16_t* WSB = (const bf16_t*)(p.ws + WS_WS) + (size_t)li * 8 * 128 * 128;
    const float* lng = p.in[9] + li * D; const float* lnb = p.in[10] + li * D; const float* bs = p.in[12] + li * 8 * 128;
    f32x2_t* stats = (f32x2_t*)(lds + 128 * VSTR);
    unsigned char* VTl = lds;
    for (int c = blockIdx.x; c < M / 128; c += gridDim.x) {
        const size_t row0 = (size_t)c * 128;
#pragma unroll 8
        for (int i = 0; i < 16; ++i) {
            const int row = w * 16 + i;
            const u32x4* src = (const u32x4*)(Z + (row0 + row) * SGU_IN + 1024 + 16 * lane);
            const u32x4 a = src[0], bq = src[1];
            float x[16]; x[0] = bf_lo(a.x); x[1] = bf_hi(a.x); x[2] = bf_lo(a.y); x[3] = bf_hi(a.y); x[4] = bf_lo(a.z); x[5] = bf_hi(a.z); x[6] = bf_lo(a.w); x[7] = bf_hi(a.w);
            x[8] = bf_lo(bq.x); x[9] = bf_hi(bq.x); x[10] = bf_lo(bq.y); x[11] = bf_hi(bq.y); x[12] = bf_lo(bq.z); x[13] = bf_hi(bq.z); x[14] = bf_lo(bq.w); x[15] = bf_hi(bq.w);
            float s = 0.f;
#pragma unroll
            for (int e = 0; e < 16; ++e) s += x[e];
            const float mean = wave_sum(s) * (1.0f / 1024.0f);
            float q = 0.f;
#pragma unroll
            for (int e = 0; e < 16; ++e) { const float d = x[e] - mean; q += d * d; }
            const float rstd = rsqrtf(wave_sum(q) * (1.0f / 1024.0f) + EPS);
            if (lane == 0) stats[row] = (f32x2_t){mean, rstd};
        }
        __syncthreads();
        const int q = tid & 127; const f32x2_t stq = stats[q];
        const int pt = w & 3, dh = w >> 2;
        u32x4 vraw[4];
#pragma unroll
        for (int i = 0; i < 4; ++i) vraw[i] = *(const u32x4*)(Z + (row0 + q) * SGU_IN + 1024 + 8 * ((tid >> 7) + 4 * i));
#pragma unroll 1
        for (int g = 0; g < 8; ++g) {
#pragma unroll
            for (int i = 0; i < 4; ++i) { const int dch = (tid >> 7) + 4 * i; const int dcol = g * 128 + 8 * dch; const u32x4 raw = vraw[i];
                float x[8]; x[0] = bf_lo(raw.x); x[1] = bf_hi(raw.x); x[2] = bf_lo(raw.y); x[3] = bf_hi(raw.y); x[4] = bf_lo(raw.z); x[5] = bf_hi(raw.z); x[6] = bf_lo(raw.w); x[7] = bf_hi(raw.w);
                const f32x4 ga = *(const f32x4*)(lng + dcol), gb = *(const f32x4*)(lng + dcol + 4), ba = *(const f32x4*)(lnb + dcol), bb = *(const f32x4*)(lnb + dcol + 4);
                const float gg[8] = {ga[0], ga[1], ga[2], ga[3], gb[0], gb[1], gb[2], gb[3]}, bbv[8] = {ba[0], ba[1], ba[2], ba[3], bb[0], bb[1], bb[2], bb[3]};
#pragma unroll
                for (int e = 0; e < 8; ++e) { const float y = (x[e] - stq.x) * stq.y * gg[e] + bbv[e];
                    *(bf16_t*)(VTl + (8 * dch + e) * VSTR + q * 2) = (bf16_t)(pk2(y, 0.f) & 0xffff); } }
            if (g < 7) {
#pragma unroll
                for (int i = 0; i < 4; ++i) vraw[i] = *(const u32x4*)(Z + (row0 + q) * SGU_IN + 1024 + (g + 1) * 128 + 8 * ((tid >> 7) + 4 * i));
            }
            bf16x8 af[8];
            { const bf16_t* ap = WSB + (size_t)g * 128 * 128 + (32 * pt + r32) * 128 + 8 * hi;
#pragma unroll
              for (int k = 0; k < 8; ++k) af[k] = *(const bf16x8*)(ap + 16 * k); }
            float bsv[16]; bf16_t uu[2][16];
#pragma unroll
            for (int r = 0; r < 16; ++r) { const int pr = 32 * pt + (r & 3) + 8 * (r >> 2) + 4 * hi; bsv[r] = bs[g * 128 + pr];
                uu[0][r] = Z[(row0 + pr) * SGU_IN + g * 128 + 64 * dh + r32]; uu[1][r] = Z[(row0 + pr) * SGU_IN + g * 128 + 64 * dh + 32 + r32]; }
            __syncthreads();
#pragma unroll
            for (int nt = 0; nt < 2; ++nt) {
                f32x16 acc;
#pragma unroll
                for (int r = 0; r < 16; ++r) acc[r] = 0.f;
                const unsigned char* bp = VTl + (64 * dh + 32 * nt + r32) * VSTR + hi * 16;
#pragma unroll
                for (int k = 0; k < 8; ++k) { const bf16x8 bfr = *(const bf16x8*)(bp + k * 32); acc = MFMA32(af[k], bfr, acc); }
                const int dcol = g * 128 + 64 * dh + 32 * nt + r32;
#pragma unroll
                for (int r = 0; r < 16; ++r) { const int pr = 32 * pt + (r & 3) + 8 * (r >> 2) + 4 * hi;
                    const float mixed = acc[r] + bsv[r];
                    Y[(row0 + pr) * D + dcol] = (bf16_t)(pk2(bf1(uu[nt][r]) * mixed, 0.f) & 0xffff); }
            }
            __syncthreads();
        }
    }
}
#define LAS __attribute__((address_space(3)))
#define XB_TMO      128
#define XB_XCNT(j)  (256  + 64 * (j))
#define XB_XSUB(j)  (1280 + 64 * (j))
#define XB_XGEN(j)  (2304 + 64 * (j))
#define XB_TOP      3328
#define XB_TOPGEN   3392
#define XCD_BAR_WORDS 3456
#define XB_SPIN_CAP (1u << 18)

__device__ __forceinline__ unsigned xb_ld(unsigned* p)              { return __hip_atomic_load(p, __ATOMIC_RELAXED, __HIP_MEMORY_SCOPE_AGENT); }
__device__ __forceinline__ unsigned xb_add(unsigned* p, unsigned v) { return __hip_atomic_fetch_add(p, v, __ATOMIC_RELAXED, __HIP_MEMORY_SCOPE_AGENT); }
__device__ __forceinline__ unsigned xb_xcc_id() { return (unsigned)__builtin_amdgcn_s_getreg((3 << 11) | 20) & 0xFu; }
#define XB_SPIN(cond, bar) do { unsigned _sp = 0; while (cond) { __builtin_amdgcn_s_sleep(1); \
    if ((++_sp & 255u) == 0u) { if (xb_ld(&(bar)[XB_TMO])) break; if (_sp > XB_SPIN_CAP) { atomicAdd(&(bar)[XB_TMO], 1u); break; } } } } while (0)

struct XcdBarrier {
    unsigned* bar; unsigned x;
    volatile LAS unsigned* st;
};

__device__ __forceinline__ XcdBarrier xcd_barrier_post(unsigned* bar, volatile LAS unsigned* st) {
    XcdBarrier b; b.bar = bar; b.x = xb_xcc_id(); b.st = st;
    if (threadIdx.x == 0) (void)xb_add(&bar[XB_XCNT(b.x)], 1u);
    return b;
}
__device__ __forceinline__ void xcd_barrier_complete(unsigned* bar, unsigned x, unsigned& nloc, unsigned& nx) {
    const unsigned G = gridDim.x * gridDim.y * gridDim.z;
    unsigned sum, cnt, mine, sp = 0u;
    for (;;) {
        sum = 0u; cnt = 0u; mine = 0u;
#pragma unroll
        for (unsigned j = 0; j < 16; ++j) { const unsigned c = xb_ld(&bar[XB_XCNT(j)]); sum += c; cnt += (c > 0u) ? 1u : 0u; mine = (j == x) ? c : mine; }
        if (sum == G) break;
        __builtin_amdgcn_s_sleep(1);
        if ((++sp & 255u) == 0u) { if (xb_ld(&bar[XB_TMO])) break; if (sp > XB_SPIN_CAP) { atomicAdd(&bar[XB_TMO], 1u); break; } }
    }
    nloc = mine > 0u ? mine : 1u; nx = cnt > 0u ? cnt : 1u;
}

__device__ __forceinline__ void xcd_barrier(const XcdBarrier& b) {
    asm volatile("s_waitcnt vmcnt(0)" ::: "memory");
    __syncthreads();
    if (threadIdx.x == 0) {
        unsigned* bar = b.bar;
        __builtin_amdgcn_s_waitcnt(0);
        unsigned nloc = b.st[0], nx = b.st[1];
        if (nloc == 0u) { xcd_barrier_complete(bar, b.x, nloc, nx); b.st[0] = nloc; b.st[1] = nx; }
        const unsigned old = xb_add(&bar[XB_XSUB(b.x)], 1u);
        const unsigned gen = old / nloc;
        if (old + 1u == (gen + 1u) * nloc) {
            __builtin_amdgcn_fence(__ATOMIC_RELEASE, "agent");
            asm volatile("s_waitcnt vmcnt(0)" ::: "memory");
            const unsigned og = xb_add(&bar[XB_TOP], 1u);
            const unsigned tg = og / nx;
            if (og + 1u == (tg + 1u) * nx) xb_add(&bar[XB_TOPGEN], 1u);
            else XB_SPIN(xb_ld(&bar[XB_TOPGEN]) == tg, bar);
            __builtin_amdgcn_fence(__ATOMIC_ACQUIRE, "agent");
            xb_add(&bar[XB_XGEN(b.x)], 1u);
            asm volatile("s_waitcnt vmcnt(0)" ::: "memory");
        } else {
            XB_SPIN(xb_ld(&bar[XB_XGEN(b.x)]) == gen, bar);
            __builtin_amdgcn_fence(__ATOMIC_ACQUIRE, "agent");
            asm volatile("s_waitcnt vmcnt(0)" ::: "memory");
        }
    }
    __syncthreads();
}
__host__ __device__ __forceinline__ bool phase_exists(int ph) { if (ph == 0 || ph == NPHASE - 1) return true; const int L = (ph - 1) >> 3, s = (ph - 1) & 7; return !((L & 1) && s == 3) && s != 0 && s != 5 && !(!(L & 1) && s == 2); }

__device__ __forceinline__ void run_phase(const Params& p, int ph, unsigned char* lds) {
    PG8_LAS unsigned char* lds3 = (PG8_LAS unsigned char*)lds;
    bf16_t* XN = (bf16_t*)(p.ws + WS_XN);
#ifndef NO_PRO
    if (ph == 0) { phase_prologue(p, lds); phase_cast_x(p.in[0], XN, (float*)(p.ws + WS_SSQ2)); return; }
#endif
    if (ph == NPHASE - 1) { phase_final_norm(XN, p.out, p.in[17]); return; }
    const int L = (ph - 1) >> 3, s = (ph - 1) & 7, li = L >> 1; const bool att = !(L & 1);
    float* SSQ = (float*)(p.ws + WS_SSQ2);
#ifndef NO_G1
    if (s == 1 && att) {
        pg8::Gemm g{XN, (const bf16_t*)(p.ws + WS_WATT_IN) + (size_t)li * ATT_IN * D, M, ATT_IN, D};
        pg8::EpiAttIn E{(bf16_t*)(p.ws + WS_BIG + BIG_PROJ), (bf16_t*)(p.ws + WS_BIG + BIG_VT), SSQ, (const pg8::f32x2*)(p.ws + WS_ROPE1), (const pg8::f32x2*)(p.ws + WS_ROPER), (const pg8::f32x2*)(p.ws + WS_ROPEC), p.in[4] + li * 64, p.in[5] + li * 64};
        pg8::StaticOrder S; S.init(g.M, g.N, (int)gridDim.x, (int)blockIdx.x);
        pg8::gemm_phase<pg8::EpiAttIn, pg8::StaticOrder, true, true>(lds3, g, S, E);
        return;
    }
    if (s == 1 || s == 6) {
        pg8::Gemm g; pg8::EpiBf16 E;
        if (s == 6)   { g = pg8::Gemm{XN, (const bf16_t*)(p.ws + WS_W1) + (size_t)L * DFF * D, M, DFF, D}; E = pg8::EpiBf16{(bf16_t*)(p.ws + WS_BIG + BIG_HID), DFF, 1, SSQ}; }
        else          { g = pg8::Gemm{XN, (const bf16_t*)(p.ws + WS_WSGU_IN) + (size_t)li * SGU_IN * D, M, SGU_IN, D}; E = pg8::EpiBf16{(bf16_t*)(p.ws + WS_BIG + BIG_Z), SGU_IN, 2, SSQ}; }
        pg8::StaticOrder S; S.init(g.M, g.N, (int)gridDim.x, (int)blockIdx.x);
        pg8::gemm_phase<pg8::EpiBf16, pg8::StaticOrder, true, true>(lds3, g, S, E);
        return;
    }
#endif
#ifndef NO_G2
    if (s == 4 || s == 7) {
        pg8::Gemm g; pg8::EpiResid E;
        if (s == 7)   { g = pg8::Gemm{(const bf16_t*)(p.ws + WS_BIG + BIG_HID), (const bf16_t*)(p.ws + WS_W2) + (size_t)L * D * DFF, M, D, DFF}; E = pg8::EpiResid{XN, SSQ, D}; }
        else if (att) { g = pg8::Gemm{(const bf16_t*)(p.ws + WS_BIG + BIG_O), (const bf16_t*)(p.ws + WS_WATT_OUT) + (size_t)li * D * D, M, D, D}; E = pg8::EpiResid{XN, SSQ, D}; }
        else          { g = pg8::Gemm{(const bf16_t*)(p.ws + WS_BIG + BIG_Y), (const bf16_t*)(p.ws + WS_WSGU_OUT) + (size_t)li * D * D, M, D, D}; E = pg8::EpiResid{XN, SSQ, D}; }
        pg8::StaticOrder S; S.init(g.M, g.N, (int)gridDim.x, (int)blockIdx.x, s == 7 ? 1 : 0);
        pg8::gemm_phase<pg8::EpiResid, pg8::StaticOrder, true, true>(lds3, g, S, E);
        return;
    }
#endif
#ifndef NO_PREP
    if (s == 2 && att) { phase_prep(p, li); return; }
#endif
#ifndef NO_SGU
    if (s == 2 && !att) { phase_sgu_mix(p, li, lds); return; }
#endif
#ifndef NO_ATTN
    if (s == 3) { if (att) phase_attn(p, li, lds); return; }
#endif
}

__device__ __forceinline__ void xcd_barrier_work(const XcdBarrier& b, const Params& p, int kbar, unsigned char* lds) {
    asm volatile("s_waitcnt vmcnt(0)" ::: "memory");
    __syncthreads();
    if (threadIdx.x == 0) {
        unsigned* bar = b.bar;
        __builtin_amdgcn_s_waitcnt(0);
        unsigned nloc = b.st[0], nx = b.st[1];
        if (nloc == 0u) { xcd_barrier_complete(bar, b.x, nloc, nx); b.st[0] = nloc; b.st[1] = nx; }
        const unsigned old = xb_add(&bar[XB_XSUB(b.x)], 1u);
        const unsigned gen = old / nloc;
        if (old + 1u == (gen + 1u) * nloc) {
            __builtin_amdgcn_fence(__ATOMIC_RELEASE, "agent");
            asm volatile("s_waitcnt vmcnt(0)" ::: "memory");
            const unsigned og = xb_add(&bar[XB_TOP], 1u);
            const unsigned tg = og / nx;
            if (og + 1u == (tg + 1u) * nx) xb_add(&bar[XB_TOPGEN], 1u);
            else XB_SPIN(xb_ld(&bar[XB_TOPGEN]) == tg, bar);
            __builtin_amdgcn_fence(__ATOMIC_ACQUIRE, "agent");
            xb_add(&bar[XB_XGEN(b.x)], 1u);
            asm volatile("s_waitcnt vmcnt(0)" ::: "memory");
        } else {
            XB_SPIN(xb_ld(&bar[XB_XGEN(b.x)]) == gen, bar);
            __builtin_amdgcn_fence(__ATOMIC_ACQUIRE, "agent");
            asm volatile("s_waitcnt vmcnt(0)" ::: "memory");
        }
    }
    {
        const int wave = __builtin_amdgcn_readfirstlane(threadIdx.x >> 6);
        if (wave != 0 && gridDim.x == 256) deferred_convert_item(p, (kbar - 1) * 1792 + (int)blockIdx.x * 7 + (wave - 1), lds, wave, threadIdx.x & 63);
    }
    __syncthreads();
}
__global__ void __launch_bounds__(512, 2) mega_fwd(Params p) {
    extern __shared__ __attribute__((aligned(16))) unsigned char lds[];
    cg::grid_group grid = cg::this_grid();
    if (p.ph_lo < 0) grid.sync();
    volatile LAS unsigned* MISC = (volatile LAS unsigned*)((LAS unsigned char*)lds + 131072 + 320);
    if (threadIdx.x < 32) MISC[threadIdx.x] = 0u;
    __syncthreads();
    XcdBarrier bar = xcd_barrier_post((unsigned*)(p.ws + WS_CTL), MISC + 8);
    bool first = true; int kbar = 0;
    for (int ph = p.ph_lo; ph < p.ph_hi; ++ph) {
        if (!phase_exists(ph)) continue;
        if (!first) { unsigned stoff = 131072 + 320 + 32; asm volatile("" : "+s"(stoff)); bar.st = (volatile LAS unsigned*)((LAS unsigned char*)lds + stoff); ++kbar; xcd_barrier_work(bar, p, kbar, lds); }
        first = false;
        run_phase(p, ph, lds);
        __syncthreads();
    }
}

extern "C" void kernel_launch(void* const* d_in, const int* in_sizes, int n_in, void* d_out, int out_size, void* d_ws, size_t ws_size, hipStream_t stream) {
    static int grid = 0;
    if (grid == 0) {
        if (n_in != 18 || in_sizes[0] != M * D || out_size != M * D || ws_size < WS_END) { fprintf(stderr, "kernel_launch: unexpected shapes (n_in %d, in0 %d, out %d, ws %zu); nothing launched\n", n_in, n_in > 0 ? in_sizes[0] : -1, out_size, ws_size); grid = -1; return; }
        int dev = 0, cus = 0, per_cu = 0;
        if (hipGetDevice(&dev) != hipSuccess || hipDeviceGetAttribute(&cus, hipDeviceAttributeMultiprocessorCount, dev) != hipSuccess) { grid = -1; return; }
        if (hipFuncSetAttribute((const void*)mega_fwd, hipFuncAttributeMaxDynamicSharedMemorySize, LDS_BYTES) != hipSuccess) { fprintf(stderr, "kernel_launch: hipFuncSetAttribute failed\n"); grid = -1; return; }
        if (hipOccupancyMaxActiveBlocksPerMultiprocessor(&per_cu, (const void*)mega_fwd, 512, LDS_BYTES) != hipSuccess || per_cu < 1) { fprintf(stderr, "kernel_launch: occupancy query says %d\n", per_cu); per_cu = 1; }
        (void)hipGetLastError();
        grid = cus * per_cu;
    }
    if (grid < 0) return;
    if (hipMemsetAsync((char*)d_ws + WS_CTL, 0, 65536, stream) != hipSuccess) { fprintf(stderr, "kernel_launch: memset failed\n"); return; }
    Params p{};
    for (int i = 0; i < 18; ++i) p.in[i] = (const float*)d_in[i];
    p.out = (float*)d_out; p.ws = (unsigned char*)d_ws;
#if MK_ONE_LAUNCH
    p.ph_lo = 0; p.ph_hi = NPHASE;
    void* args[] = {&p};
    hipError_t e = hipLaunchCooperativeKernel((const void*)mega_fwd, dim3(grid), dim3(512), args, LDS_BYTES, stream);
    if (e != hipSuccess) fprintf(stderr, "cooperative launch failed: %s (grid %d)\n", hipGetErrorString(e), grid);
#else
    for (int ph = 0; ph < NPHASE; ++ph) {
        if (!phase_exists(ph)) continue;
        p.ph_lo = ph; p.ph_hi = ph + 1;
        hipLaunchKernelGGL(mega_fwd, dim3(grid), dim3(512), LDS_BYTES, stream, p);
    }
#endif
}
```
